# Optimizing an MI355X kernel written in HIP

```python
import jax, jax.numpy as jnp
from jax import lax
import numpy as np

D_MODEL = 1024
BATCH = 8
SEQ = 4096
DEPTH = 1

GRID_W = 64
CTX_LEN = 256

GLA_HEADS = 4
GLA_DK = 64
GLA_DV = 128
GLA_GATE_RANK = 16
GLA_GATE_NORM = 16.0
GLA_CHUNK = 64
GLA_WIDTH = GLA_HEADS * GLA_DV

MLA_HEADS = 8
MLA_NOPE = 64
MLA_ROPE = 32
MLA_DV = 64
MLA_Q_RANK = 256
MLA_KV_RANK = 128
MLA_WIDTH = MLA_HEADS * MLA_DV
Q_BLOCK = 128
ROPE_BASE = 10000.0
ROPE_AXIS_PAIRS = MLA_ROPE // 4

MIX_WIDTH = GLA_WIDTH + MLA_WIDTH
IN_SPLITS = (GLA_HEADS * GLA_DK,
             GLA_HEADS * GLA_DK,
             GLA_WIDTH,
             GLA_GATE_RANK,
             GLA_GATE_RANK,
             GLA_WIDTH,
             MLA_Q_RANK,
             MLA_KV_RANK,
             MLA_ROPE)
IN_WIDTH = 1984

N_GROUPS = 4
EXPERTS_PER_GROUP = 4
N_EXPERTS = N_GROUPS * EXPERTS_PER_GROUP
TOP_K = 2
D_EXPERT = 256

DEEPNORM_ALPHA = (2.0 * DEPTH) ** 0.25
DEEPNORM_BETA = (8.0 * DEPTH) ** -0.25
EPS = 1e-6

kernel_name = "hymba_gla_mla_hmoe_dit_block"


def layernorm(x, g, b):
    xf = x.astype(jnp.float32)
    mu = xf.mean(-1, keepdims=True)
    var = jnp.square(xf - mu).mean(-1, keepdims=True)
    return ((xf - mu) * lax.rsqrt(var + EPS)).astype(x.dtype) * g + b


def rmsnorm(x, g):
    xf = x.astype(jnp.float32)
    return (xf * lax.rsqrt(jnp.square(xf).mean(-1, keepdims=True) + EPS)).astype(x.dtype) * g


def modulate(x, shift, scale):
    return x * (1.0 + scale) + shift


def rope_half(x, ang):
    h = x.shape[-1] // 2
    cos = jnp.cos(ang).astype(x.dtype)
    sin = jnp.sin(ang).astype(x.dtype)
    x1, x2 = x[..., :h], x[..., h:]
    return jnp.concatenate([x1 * cos - x2 * sin, x2 * cos + x1 * sin], axis=-1)


def rope2d(x, ang_row, ang_col):
    half = x.shape[-1] // 2
    return jnp.concatenate([rope_half(x[..., :half], ang_row),
                            rope_half(x[..., half:], ang_col)], axis=-1)


def gla_chunked(q, k, v, log_g, s0):
    B, T, H, DK = q.shape
    DV = v.shape[-1]
    N = T // GLA_CHUNK

    def to_chunks(a):
        return a.astype(jnp.float32).reshape(B, N, GLA_CHUNK, H, a.shape[-1]).transpose(0, 3, 1, 2, 4)

    qc = to_chunks(q) * (DK ** -0.5)
    kc, vc, gc = to_chunks(k), to_chunks(v), to_chunks(log_g)
    b = jnp.cumsum(gc, axis=3)
    b_last = b[:, :, :, -1:, :]
    q_e = qc * jnp.exp(b)
    k_e = kc * jnp.exp(-b)
    mask = jnp.tril(jnp.ones((GLA_CHUNK, GLA_CHUNK), dtype=bool))
    a = jnp.where(mask, jnp.einsum('bhnid,bhnjd->bhnij', q_e, k_e), 0.0)
    o_intra = jnp.einsum('bhnij,bhnjv->bhniv', a, vc)
    ds = jnp.einsum('bhncd,bhncv->bhndv', kc * jnp.exp(b_last - b), vc)
    decay = jnp.exp(b_last[:, :, :, 0, :])

    def step(s, inp):
        d_n, ds_n = inp
        return d_n[..., None] * s + ds_n, s

    s_final, s_prev = lax.scan(step, s0.astype(jnp.float32),
                               (jnp.moveaxis(decay, 2, 0), jnp.moveaxis(ds, 2, 0)))
    o_inter = jnp.einsum('bhncd,nbhdv->bhncv', q_e, s_prev)
    o = (o_intra + o_inter).transpose(0, 2, 3, 1, 4).reshape(B, T, H, DV)
    return o.astype(v.dtype), s_final


def gla_group(p_lat, p_ctx, w_gk_f, b_gk_f, w_gk_b, b_gk_b, gla_norm_g, need_ctx_out):
    def heads(p):
        q, k, v, gf, gb, r = p
        B, T, _ = q.shape
        sh = lambda a, d: a.reshape(B, T, GLA_HEADS, d)
        lg_f = jax.nn.log_sigmoid((gf @ w_gk_f + b_gk_f).astype(jnp.float32)) / GLA_GATE_NORM
        lg_b = jax.nn.log_sigmoid((gb @ w_gk_b + b_gk_b).astype(jnp.float32)) / GLA_GATE_NORM
        return sh(q, GLA_DK), sh(k, GLA_DK), sh(v, GLA_DV), sh(lg_f, GLA_DK), sh(lg_b, GLA_DK), sh(r, GLA_DV)

    def flip(a):
        return jnp.flip(a, axis=1)

    def out(o, r):
        B, T = o.shape[:2]
        return (rmsnorm(o, gla_norm_g) * jax.nn.silu(r)).reshape(B, T, GLA_WIDTH)

    q, k, v, lgf, lgb, r = heads(p_lat)
    qc, kc, vc, lgf_c, lgb_c, rc = heads(p_ctx)
    zeros = jnp.zeros((q.shape[0], GLA_HEADS, GLA_DK, GLA_DV), jnp.float32)
    o_cf, s_f = gla_chunked(qc, kc, vc, lgf_c, zeros)
    o_cb, s_b = gla_chunked(flip(qc), flip(kc), flip(vc), flip(lgb_c), zeros)
    o_f, _ = gla_chunked(q, k, v, lgf, s_f)
    o_b, _ = gla_chunked(flip(q), flip(k), flip(v), flip(lgb), s_b)
    lat = out(o_f + flip(o_b), r)
    ctx_out = out(o_cf + flip(o_cb), rc) if need_ctx_out else None
    return lat, ctx_out


def mla_group(p_lat, p_ctx, ang_row, ang_col, mla_q_norm_g, w_uq, mla_kv_norm_g, w_ukv, need_ctx_out):
    scale = (MLA_NOPE + MLA_ROPE) ** -0.5

    def project(p, rotate):
        cq, ckv, kr = p
        B, T, _ = cq.shape
        q = (rmsnorm(cq, mla_q_norm_g) @ w_uq).reshape(B, T, MLA_HEADS, MLA_NOPE + MLA_ROPE)
        qn, qr = q[..., :MLA_NOPE], q[..., MLA_NOPE:]
        kv = (rmsnorm(ckv, mla_kv_norm_g) @ w_ukv).reshape(B, T, MLA_HEADS, MLA_NOPE + MLA_DV)
        kn, v = kv[..., :MLA_NOPE], kv[..., MLA_NOPE:]
        if rotate:
            qr = rope2d(qr, ang_row[:, None, :], ang_col[:, None, :])
            kr = rope2d(kr, ang_row, ang_col)
        return qn, qr, kn, kr, v

    qn, qr, kn, kr, v = project(p_lat, True)
    qn_c, qr_c, kn_c, kr_c, v_c = project(p_ctx, False)
    B, S = qn.shape[:2]
    nb = S // Q_BLOCK

    def blocks(a):
        return a.reshape(B, nb, Q_BLOCK, *a.shape[2:]).swapaxes(0, 1)

    def attend_block(args):
        qn_i, qr_i = args
        s_lat = jnp.einsum('bqhd,bkhd->bhqk', qn_i, kn) + jnp.einsum('bqhr,bkr->bhqk', qr_i, kr)
        s_ctx = jnp.einsum('bqhd,bkhd->bhqk', qn_i, kn_c) + jnp.einsum('bqhr,bkr->bhqk', qr_i, kr_c)
        s = jnp.concatenate([s_lat, s_ctx], axis=-1).astype(jnp.float32) * scale
        p = jax.nn.softmax(s, axis=-1).astype(v.dtype)
        return (jnp.einsum('bhqk,bkhv->bqhv', p[..., :S], v)
                + jnp.einsum('bhqk,bkhv->bqhv', p[..., S:], v_c))

    o = lax.map(attend_block, (blocks(qn), blocks(qr)))
    lat = o.swapaxes(0, 1).reshape(B, S, MLA_WIDTH)
    ctx_out = None
    if need_ctx_out:
        L = qn_c.shape[1]
        s = (jnp.einsum('bqhd,bkhd->bhqk', qn_c, kn_c)
             + jnp.einsum('bqhr,bkr->bhqk', qr_c, kr_c)).astype(jnp.float32) * scale
        p = jax.nn.softmax(s, axis=-1).astype(v_c.dtype)
        ctx_out = jnp.einsum('bhqk,bkhv->bqhv', p, v_c).reshape(B, L, MLA_WIDTH)
    return lat, ctx_out


def hybrid_mixer(u_lat, u_ctx, ang_row, ang_col, w_in, w_gk_f, b_gk_f, w_gk_b, b_gk_b, gla_norm_g,
                 mla_q_norm_g, w_uq, mla_kv_norm_g, w_ukv, w_o, need_ctx_out):
    offsets = np.cumsum(IN_SPLITS)[:-1].tolist()
    p_lat = jnp.split(u_lat @ w_in, offsets, axis=-1)
    p_ctx = jnp.split(u_ctx @ w_in, offsets, axis=-1)
    g_lat, g_ctx = gla_group(p_lat[:6], p_ctx[:6], w_gk_f, b_gk_f, w_gk_b, b_gk_b, gla_norm_g, need_ctx_out)
    m_lat, m_ctx = mla_group(p_lat[6:], p_ctx[6:], ang_row, ang_col, mla_q_norm_g, w_uq,
                             mla_kv_norm_g, w_ukv, need_ctx_out)
    y_lat = jnp.concatenate([g_lat, m_lat], axis=-1) @ w_o
    y_ctx = jnp.concatenate([g_ctx, m_ctx], axis=-1) @ w_o if need_ctx_out else None
    return y_lat, y_ctx


def hier_moe(h, w_rg, b_rg, w_re, b_re, w_gate, w_up, w_down):
    shape = h.shape
    hf = h.reshape(-1, shape[-1])
    n = hf.shape[0]
    g_prob = jax.nn.softmax((hf @ w_rg + b_rg).astype(jnp.float32), axis=-1)
    p_g, g_top = lax.top_k(g_prob, 1)
    e_logits = (hf @ w_re + b_re).astype(jnp.float32).reshape(n, N_GROUPS, EXPERTS_PER_GROUP)
    e_in = e_logits[jnp.arange(n), g_top[:, 0]]
    top_p, top_i = lax.top_k(jax.nn.softmax(e_in, axis=-1), TOP_K)
    top_w = top_p / top_p.sum(-1, keepdims=True) * p_g
    expert_id = g_top * EXPERTS_PER_GROUP + top_i
    combine = jnp.einsum('nk,nke->ne', top_w,
                         jax.nn.one_hot(expert_id, N_EXPERTS, dtype=jnp.float32)).astype(h.dtype)
    out = jnp.zeros_like(hf)
    for e in range(N_EXPERTS):
        he = jax.nn.silu(hf @ w_gate[e]) * (hf @ w_up[e])
        out = out + combine[:, e:e + 1] * (he @ w_down[e])
    return out.reshape(shape)


def setup_inputs(seed: int = 0) -> dict:
    key = jax.random.key(seed)
    ks = jax.random.split(key, 32)
    f32 = jnp.float32

    def nrm(k, shape, s):
        return jax.random.normal(k, shape, f32) * s

    def gain(k, shape):
        return 1.0 + 0.02 * jax.random.normal(k, shape, f32)

    D = D_MODEL
    return {
        "x": nrm(ks[0], (BATCH, SEQ, D), 1.0),
        "c": nrm(ks[1], (BATCH, D), 1.0),
        "ctx": nrm(ks[2], (BATCH, CTX_LEN, D), 1.0),
        "c_ctx": nrm(ks[3], (D,), 1.0),
        "w_ada": nrm(ks[4], (DEPTH, D, 6 * D), 0.5 * D ** -0.5),
        "b_ada": nrm(ks[5], (DEPTH, 6 * D), 0.02),
        "w_in": nrm(ks[6], (DEPTH, D, IN_WIDTH), D ** -0.5),
        "w_gk_f": nrm(ks[7], (DEPTH, GLA_GATE_RANK, GLA_HEADS * GLA_DK), GLA_GATE_RANK ** -0.5),
        "b_gk_f": nrm(ks[8], (DEPTH, GLA_HEADS * GLA_DK), 0.1),
        "w_gk_b": nrm(ks[9], (DEPTH, GLA_GATE_RANK, GLA_HEADS * GLA_DK), GLA_GATE_RANK ** -0.5),
        "b_gk_b": nrm(ks[10], (DEPTH, GLA_HEADS * GLA_DK), 0.1),
        "gla_norm_g": gain(ks[11], (DEPTH, GLA_DV)),
        "mla_q_norm_g": gain(ks[12], (DEPTH, MLA_Q_RANK)),
        "w_uq": nrm(ks[13], (DEPTH, MLA_Q_RANK, MLA_HEADS * (MLA_NOPE + MLA_ROPE)), MLA_Q_RANK ** -0.5),
        "mla_kv_norm_g": gain(ks[14], (DEPTH, MLA_KV_RANK)),
        "w_ukv": nrm(ks[15], (DEPTH, MLA_KV_RANK, MLA_HEADS * (MLA_NOPE + MLA_DV)), MLA_KV_RANK ** -0.5),
        "w_o": nrm(ks[16], (DEPTH, MIX_WIDTH, D), DEEPNORM_BETA * MIX_WIDTH ** -0.5),
        "ln1_g": gain(ks[17], (DEPTH, D)),
        "ln1_b": nrm(ks[18], (DEPTH, D), 0.02),
        "w_router_group": nrm(ks[19], (DEPTH, D, N_GROUPS), D ** -0.5),
        "b_router_group": nrm(ks[20], (DEPTH, N_GROUPS), 0.01),
        "w_router_expert": nrm(ks[21], (DEPTH, D, N_EXPERTS), D ** -0.5),
        "b_router_expert": nrm(ks[22], (DEPTH, N_EXPERTS), 0.01),
        "w_expert_gate": nrm(ks[23], (DEPTH, N_EXPERTS, D, D_EXPERT), D ** -0.5),
        "w_expert_up": nrm(ks[24], (DEPTH, N_EXPERTS, D, D_EXPERT), D ** -0.5),
        "w_expert_down": nrm(ks[25], (DEPTH, N_EXPERTS, D_EXPERT, D), DEEPNORM_BETA * D_EXPERT ** -0.5),
        "ln2_g": gain(ks[26], (DEPTH, D)),
        "ln2_b": nrm(ks[27], (DEPTH, D), 0.02),
    }


def reference(x, c, ctx, c_ctx, w_ada, b_ada, w_in, w_gk_f, b_gk_f, w_gk_b, b_gk_b, gla_norm_g,
              mla_q_norm_g, w_uq, mla_kv_norm_g, w_ukv, w_o, ln1_g, ln1_b, w_router_group,
              b_router_group, w_router_expert, b_router_expert, w_expert_gate, w_expert_up,
              w_expert_down, ln2_g, ln2_b):
    seq_len = x.shape[1]
    rows = seq_len // GRID_W
    row, col = jnp.meshgrid(jnp.arange(rows), jnp.arange(GRID_W), indexing='ij')
    inv_freq = ROPE_BASE ** (-jnp.arange(ROPE_AXIS_PAIRS, dtype=jnp.float32) / ROPE_AXIS_PAIRS)
    ang_row = row.reshape(-1)[:, None].astype(jnp.float32) * inv_freq
    ang_col = col.reshape(-1)[:, None].astype(jnp.float32) * inv_freq

    for l in range(DEPTH):
        last = l == DEPTH - 1
        m_lat = jnp.split((jax.nn.silu(c) @ w_ada[l] + b_ada[l])[:, None, :], 6, axis=-1)
        m_ctx = jnp.split(jax.nn.silu(c_ctx) @ w_ada[l] + b_ada[l], 6, axis=-1)

        u_lat = modulate(x, m_lat[0], m_lat[1])
        u_ctx = modulate(ctx, m_ctx[0], m_ctx[1])
        y_lat, y_ctx = hybrid_mixer(u_lat, u_ctx, ang_row, ang_col, w_in[l], w_gk_f[l], b_gk_f[l],
                                    w_gk_b[l], b_gk_b[l], gla_norm_g[l], mla_q_norm_g[l], w_uq[l],
                                    mla_kv_norm_g[l], w_ukv[l], w_o[l], not last)
        x = layernorm(DEEPNORM_ALPHA * x + m_lat[2] * y_lat, ln1_g[l], ln1_b[l])

        h = modulate(x, m_lat[3], m_lat[4])
        y = hier_moe(h, w_router_group[l], b_router_group[l], w_router_expert[l], b_router_expert[l],
                     w_expert_gate[l], w_expert_up[l], w_expert_down[l])
        x = layernorm(DEEPNORM_ALPHA * x + m_lat[5] * y, ln2_g[l], ln2_b[l])

        if not last:
            ctx = layernorm(DEEPNORM_ALPHA * ctx + m_ctx[2] * y_ctx, ln1_g[l], ln1_b[l])
            hc = modulate(ctx, m_ctx[3], m_ctx[4])
            yc = hier_moe(hc, w_router_group[l], b_router_group[l], w_router_expert[l],
                          b_router_expert[l], w_expert_gate[l], w_expert_up[l], w_expert_down[l])
            ctx = layernorm(DEEPNORM_ALPHA * ctx + m_ctx[5] * yc, ln2_g[l], ln2_b[l])
    return x
```

```cpp
#include <hip/hip_runtime.h>
#include <hip/hip_cooperative_groups.h>
#include <cstdio>
#include <cstdint>
#include <math.h>
namespace pg8 {
#define PG8_LAS __attribute__((address_space(3)))
typedef unsigned short bf16_t;
typedef short bf16x8 __attribute__((ext_vector_type(8)));
typedef float f32x4 __attribute__((ext_vector_type(4)));
typedef unsigned u32x4 __attribute__((ext_vector_type(4)));
constexpr int BM = 256, BK = 64, HALF = 128, HTB = HALF * BK * 2  , STAGE_BYTES = 8 * HTB, NXCD = 8, WGM = 8;

__host__ __device__ __forceinline__ int lds_byte(int r, int c) { const int st = (r >> 4) * 2 + (c >> 5), rr = r & 15, cc = c & 31, ob = rr * 64 + cc * 2; return st * 1024 + (ob ^ (((ob >> 9) & 1) << 5)); }
__host__ __device__ __forceinline__ void stage_rc(int b, int& R, int& C) { const int st = b / 1024, sb = b % 1024, swz = sb ^ (((sb >> 9) & 1) << 5); R = (st >> 1) * 16 + swz / 64; C = (st & 1) * 32 + (swz % 64) / 2; }
__host__ __device__ __forceinline__ int perm32(int rho) { const int n = rho >> 4, i = rho & 15; return 8 * (i >> 2) + 4 * n + (i & 3); }

struct Unit { int pm, pn; };
struct Gemm { const bf16_t* A; const bf16_t* Bt; int M, N, K; };

struct StaticOrder {
    int nM, nN, nwg, G, c;
    __host__ __device__ void init(int M, int N, int G_, int c_) { nM = M / BM; nN = N / BM; nwg = nM * nN; G = G_; c = c_; }
    __host__ __device__ bool next(int i, Unit& u) const {
        const long L = (long)i * G + c; if (L >= nwg) return false;
        int wgid = (int)L; { const int q = nwg / NXCD, r = nwg % NXCD, xcd = wgid % NXCD, off = wgid / NXCD; wgid = (xcd < r ? xcd * (q + 1) : r * (q + 1) + (xcd - r) * q) + off; }
        const int nig = WGM * nN, gid = wgid / nig, fm = gid * WGM, gsz = (nM - fm) < WGM ? (nM - fm) : WGM;
        u.pm = fm + ((wgid % nig) % gsz); u.pn = (wgid % nig) / gsz; return true;
    }
    __device__ __forceinline__ void a_ready(const Unit&) const {}
    __device__ __forceinline__ void done(const Unit&) const {}
};

template <class Epi, class Sched, bool ALIGN_EPI = false, bool SP2 = false>
__device__ __forceinline__ void gemm_phase(PG8_LAS unsigned char* lds, const Gemm g, const Sched& S, const Epi& E) {
    const int tid = threadIdx.x, wid = __builtin_amdgcn_readfirstlane(tid >> 6), lane = tid & 63, wr = wid >> 2, wc = wid & 3, fr = lane & 15, fq = lane >> 4;
    const int K = g.K, nt = K / BK;
    unsigned voffA[2], voffB[2];
#pragma unroll
    for (int i = 0; i < 2; ++i) { int R, C; stage_rc(tid * 16 + i * 8192, R, C); const int Rb = Epi::PERM ? ((R & ~31) + perm32(R & 31)) : R;
        voffA[i] = (unsigned)(R * K + C) * 2u; voffB[i] = (unsigned)(Rb * K + C) * 2u; }
    const size_t kstep = (size_t)(BK * 2);
    const size_t hstep = (size_t)HALF * K * 2;
    const size_t tstep = 2 * hstep;
    const unsigned ldsw = (unsigned)wid * 1024u;
    const int aoff = lds_byte(wr * 64 + fr, fq * 8), boff = lds_byte(wc * 32 + fr, fq * 8);
#define PG8_SA(b, h) (((b) * 2 + (h)) * HTB)
#define PG8_SB(b, h) ((4 + (b) * 2 + (h)) * HTB)
#define PG8_STAGE(bufoff, gbase, voff) do { _Pragma("unroll") for (int _i = 0; _i < 2; ++_i) \
        __builtin_amdgcn_global_load_lds((const unsigned*)((const char*)(gbase) + (voff)[_i]), (PG8_LAS unsigned*)(lds + (bufoff) + ldsw + _i * 8192), 16, 0, 0); } while (0)
#define PG8_LDA(dst, b, h) do { _Pragma("unroll") for (int m = 0; m < 4; ++m) _Pragma("unroll") for (int k = 0; k < 2; ++k) dst[m][k] = *(const PG8_LAS bf16x8*)(lds + PG8_SA(b, h) + aoff + m * 2048 + k * 1024); } while (0)
#define PG8_LDB(dst, b, h) do { _Pragma("unroll") for (int n = 0; n < 2; ++n) _Pragma("unroll") for (int k = 0; k < 2; ++k) dst[n][k] = *(const PG8_LAS bf16x8*)(lds + PG8_SB(b, h) + boff + n * 2048 + k * 1024); } while (0)
#define PG8_MMA(ai, bj, At, Bt) do { __builtin_amdgcn_s_setprio(1); _Pragma("unroll") for (int m = 0; m < 4; ++m) _Pragma("unroll") for (int n = 0; n < 2; ++n) _Pragma("unroll") for (int k = 0; k < 2; ++k) \
        acc[ai][bj][m][n] = __builtin_amdgcn_mfma_f32_16x16x32_bf16(Bt[n][k], At[m][k], acc[ai][bj][m][n], 0, 0, 0); __builtin_amdgcn_s_setprio(0); } while (0)
#define PG8_WAIT_V(n) asm volatile("s_waitcnt vmcnt(" #n ")" ::: "memory")
#define PG8_WAIT_L(n) asm volatile("s_waitcnt lgkmcnt(" #n ")" ::: "memory")
#define PG8_BAR __builtin_amdgcn_s_barrier()
#define PG8_SCHED __builtin_amdgcn_sched_barrier(0)
    Unit cur, nxt; int ui = 0;
    if (!S.next(0, cur)) return;
    f32x4 acc[2][2][4][2];
#pragma unroll
    for (int a = 0; a < 2; ++a)
#pragma unroll
        for (int b = 0; b < 2; ++b)
#pragma unroll
            for (int m = 0; m < 4; ++m)
#pragma unroll
                for (int n = 0; n < 2; ++n) acc[a][b][m][n] = (f32x4){0.f, 0.f, 0.f, 0.f};
    bf16x8 At[4][2], B0[2][2], B1[2][2];
    const char* cA = (const char*)g.A + (size_t)cur.pm * tstep; const char* cB = (const char*)g.Bt + (size_t)cur.pn * tstep;
    S.a_ready(cur);
    if constexpr (SP2) {
        PG8_STAGE(PG8_SB(0, 0), cB, voffB); PG8_STAGE(PG8_SB(0, 1), cB + hstep, voffB); PG8_STAGE(PG8_SA(0, 0), cA, voffA); PG8_STAGE(PG8_SA(0, 1), cA + hstep, voffA);
        if (wr == 1) PG8_BAR;
        PG8_WAIT_V(2); PG8_BAR;
        PG8_STAGE(PG8_SB(1, 0), cB + kstep, voffB); PG8_STAGE(PG8_SA(1, 0), cA + kstep, voffA); PG8_STAGE(PG8_SB(1, 1), cB + hstep + kstep, voffB);
        PG8_WAIT_V(6); PG8_BAR;
    } else {
        PG8_STAGE(PG8_SB(0, 0), cB, voffB); PG8_STAGE(PG8_SA(0, 0), cA, voffA); PG8_STAGE(PG8_SB(0, 1), cB + hstep, voffB); PG8_STAGE(PG8_SA(0, 1), cA + hstep, voffA);
        if (wr == 1) PG8_BAR;
        PG8_WAIT_V(4); PG8_BAR;
        PG8_STAGE(PG8_SB(1, 0), cB + kstep, voffB); PG8_STAGE(PG8_SA(1, 0), cA + kstep, voffA); PG8_STAGE(PG8_SB(1, 1), cB + hstep + kstep, voffB);
        PG8_WAIT_V(6); PG8_BAR;
    }
    for (;;) {
        const bool has_next = S.next(ui + 1, nxt);
        const char* nA = has_next ? (const char*)g.A + (size_t)nxt.pm * tstep : cA; const char* nB = has_next ? (const char*)g.Bt + (size_t)nxt.pn * tstep : cB;
        for (int t = 0; t < nt; t += 2) {
            const bool last = (t == nt - 2);
            const char* a1 = cA + (size_t)(t + 1) * kstep;
            const char* a2 = last ? nA : cA + (size_t)(t + 2) * kstep; const char* b2 = last ? nB : cB + (size_t)(t + 2) * kstep;
            const char* a3 = a2 + kstep; const char* b3 = b2 + kstep;
            if (last && has_next) S.a_ready(nxt);
            if constexpr (SP2) {
            PG8_LDB(B0, 0, 0); PG8_LDB(B1, 0, 1); PG8_SCHED; PG8_LDA(At, 0, 0); PG8_STAGE(PG8_SA(1, 1), a1 + hstep, voffA);
            PG8_WAIT_V(8); PG8_WAIT_L(0); PG8_BAR; PG8_MMA(0, 0, At, B0); PG8_MMA(0, 1, At, B1); PG8_BAR; PG8_SCHED;
            PG8_LDA(At, 0, 1); PG8_STAGE(PG8_SB(0, 0), b2, voffB); PG8_STAGE(PG8_SB(0, 1), b2 + hstep, voffB); PG8_STAGE(PG8_SA(0, 0), a2, voffA);
            PG8_WAIT_V(8); PG8_WAIT_L(0); PG8_BAR; PG8_MMA(1, 0, At, B0); PG8_MMA(1, 1, At, B1); PG8_BAR; PG8_SCHED;
            PG8_LDB(B0, 1, 0); PG8_LDB(B1, 1, 1); PG8_SCHED; PG8_LDA(At, 1, 0); PG8_STAGE(PG8_SA(0, 1), a2 + hstep, voffA);
            PG8_WAIT_V(8); PG8_WAIT_L(0); PG8_BAR; PG8_MMA(0, 0, At, B0); PG8_MMA(0, 1, At, B1); PG8_BAR; PG8_SCHED;
            PG8_LDA(At, 1, 1); PG8_STAGE(PG8_SB(1, 0), b3, voffB); PG8_STAGE(PG8_SB(1, 1), b3 + hstep, voffB); PG8_STAGE(PG8_SA(1, 0), a3, voffA);
            PG8_WAIT_V(8); PG8_WAIT_L(0); PG8_BAR; PG8_MMA(1, 0, At, B0); PG8_MMA(1, 1, At, B1); PG8_BAR; PG8_SCHED;
            } else {
            PG8_LDB(B0, 0, 0); PG8_SCHED; PG8_LDA(At, 0, 0); PG8_STAGE(PG8_SA(1, 1), a1 + hstep, voffA);
            PG8_WAIT_L(8); PG8_BAR; PG8_WAIT_L(0); PG8_MMA(0, 0, At, B0); PG8_BAR; PG8_SCHED;
            PG8_LDB(B1, 0, 1); PG8_STAGE(PG8_SB(0, 0), b2, voffB);
            PG8_BAR; PG8_WAIT_L(0); PG8_MMA(0, 1, At, B1); PG8_BAR;
            PG8_LDA(At, 0, 1); PG8_STAGE(PG8_SA(0, 0), a2, voffA);
            PG8_BAR; PG8_WAIT_L(0); PG8_MMA(1, 0, At, B0); PG8_BAR; PG8_SCHED;
            PG8_STAGE(PG8_SB(0, 1), b2 + hstep, voffB);
            PG8_WAIT_V(6); PG8_BAR; PG8_MMA(1, 1, At, B1); PG8_BAR;
            PG8_LDB(B0, 1, 0); PG8_SCHED; PG8_LDA(At, 1, 0); PG8_STAGE(PG8_SA(0, 1), a2 + hstep, voffA);
            PG8_WAIT_L(8); PG8_BAR; PG8_WAIT_L(0); PG8_MMA(0, 0, At, B0); PG8_BAR; PG8_SCHED;
            PG8_LDB(B1, 1, 1); PG8_STAGE(PG8_SB(1, 0), b3, voffB);
            PG8_BAR; PG8_WAIT_L(0); PG8_MMA(0, 1, At, B1); PG8_BAR;
            PG8_LDA(At, 1, 1); PG8_STAGE(PG8_SA(1, 0), a3, voffA);
            PG8_BAR; PG8_WAIT_L(0); PG8_MMA(1, 0, At, B0); PG8_BAR; PG8_SCHED;
            PG8_STAGE(PG8_SB(1, 1), b3 + hstep, voffB);
            PG8_WAIT_V(6); PG8_BAR; PG8_MMA(1, 1, At, B1); PG8_BAR;
            }
        }
        if constexpr (ALIGN_EPI) { if (wr == 0) PG8_BAR; }
        if constexpr (!Epi::AFTER_DRAIN) { E(acc, cur, wr, wc, fr, fq); S.done(cur); }
        if (!has_next) break;
#pragma unroll
        for (int a = 0; a < 2; ++a)
#pragma unroll
            for (int b = 0; b < 2; ++b)
#pragma unroll
                for (int m = 0; m < 4; ++m)
#pragma unroll
                    for (int n = 0; n < 2; ++n) acc[a][b][m][n] = (f32x4){0.f, 0.f, 0.f, 0.f};
        cur = nxt; cA = nA; cB = nB; ++ui;
        if constexpr (ALIGN_EPI) { if (wr == 1) PG8_BAR; }
    }
    PG8_WAIT_V(0);
    if constexpr (!ALIGN_EPI) { if (wr == 0) PG8_BAR; }
    PG8_BAR;
    if constexpr (Epi::AFTER_DRAIN) { E.fused(acc, cur, wr, wc, fr, fq, lds, wid, lane); S.done(cur); }
#undef PG8_SA
#undef PG8_SB
#undef PG8_STAGE
#undef PG8_LDA
#undef PG8_LDB
#undef PG8_MMA
#undef PG8_WAIT_V
#undef PG8_WAIT_L
#undef PG8_BAR
#undef PG8_SCHED
}
}
namespace mk {
using pg8::bf16_t; using pg8::bf16x8; using pg8::f32x4; using pg8::u32x4;
typedef float f32x8 __attribute__((ext_vector_type(8)));
typedef float f32x16 __attribute__((ext_vector_type(16)));
typedef float f32x2 __attribute__((ext_vector_type(2)));
typedef unsigned u32x2 __attribute__((ext_vector_type(2)));
#define LAS __attribute__((address_space(3)))

constexpr int NTH = 512;
constexpr int D = 1024, NB = 8, SEQ = 4096, CTXL = 256;
constexpr int NLAT = NB * SEQ;
constexpr int NCTX = NB * CTXL;
constexpr int MROWS = NLAT + NCTX;
constexpr float ALPHA = 1.189207115002721f;
constexpr float EPS = 1e-6f;
constexpr float QSCALE = 0.10206207261596575f * 1.4426950408889634f;

constexpr size_t MiB = 1u << 20;
constexpr size_t WS_MOD = 0;
constexpr size_t WS_ROPE = 1 * MiB;
constexpr size_t WS_RS = 2 * MiB;
constexpr size_t WS_CNT = 3 * MiB;
constexpr size_t WS_TOKINFO = 4 * MiB;
constexpr size_t WS_ROWTOK = 5 * MiB;
constexpr size_t WS_BAR = 3 * MiB + 65536;
constexpr size_t WS_ST1 = 6 * MiB;
constexpr size_t WS_ST2 = 10 * MiB;
constexpr size_t WS_WINT = 16 * MiB, WS_WOT = 20 * MiB, WS_WUPT = 22 * MiB;
constexpr size_t WS_U = 24 * MiB;
constexpr size_t WS_MIX = WS_U;
constexpr size_t WS_QG = 92 * MiB, WS_KG = 109 * MiB, WS_VG = 126 * MiB, WS_RG = 160 * MiB;
constexpr size_t WS_A2 = 194 * MiB;
constexpr size_t WS_KR = WS_A2 + 26738688;
constexpr size_t WS_GFB = WS_KR + 4456448;
constexpr size_t WS_LGF = 228 * MiB, WS_LGB = 262 * MiB;
constexpr size_t WS_QC = 296 * MiB, WS_KC = 344 * MiB, WS_VC = 395 * MiB;
constexpr size_t WS_DS = 429 * MiB;
constexpr size_t WS_END = 497 * MiB;
constexpr size_t WS_W1T = 296 * MiB, WS_W2T = 344 * MiB;
constexpr size_t WS_H = 92 * MiB;
constexpr size_t WS_HPERM = 156 * MiB;
constexpr size_t WS_HE = 232 * MiB;
constexpr size_t WS_NEED = 497 * MiB;

constexpr int LDS_BYTES = 140 * 1024;

struct MP { const float* in[28]; float* out; unsigned char* ws; int ph_lo, ph_hi, coop, pad; };
enum { I_X = 0, I_C, I_CTX, I_CCTX, I_WADA, I_BADA, I_WIN, I_WGKF, I_BGKF, I_WGKB, I_BGKB, I_GLAG, I_QNG, I_WUQ, I_KVNG, I_WUKV, I_WO, I_LN1G, I_LN1B,
       I_WRG, I_BRG, I_WRE, I_BRE, I_WEG, I_WEU, I_WED, I_LN2G, I_LN2B };

typedef __bf16 bf16x2_t __attribute__((ext_vector_type(2)));
__device__ __forceinline__ unsigned cvt_pk(float lo, float hi) { f32x2 v = {lo, hi}; bf16x2_t b = __builtin_convertvector(v, bf16x2_t); return __builtin_bit_cast(unsigned, b); }
__device__ __forceinline__ float bf2f(unsigned short h) { return __uint_as_float(((unsigned)h) << 16); }
__device__ __forceinline__ float bflo(unsigned w) { return __uint_as_float(w << 16); }
__device__ __forceinline__ float bfhi(unsigned w) { return __uint_as_float(w & 0xffff0000u); }
__device__ __forceinline__ float silu_f(float x) { return x / (1.f + __expf(-x)); }

__device__ __forceinline__ int grow(int b, int r) { return r < SEQ ? b * SEQ + r : NLAT + b * CTXL + (r - SEQ); }

__host__ __device__ __forceinline__ int rope_unperm(int jp) { const int half = jp >> 4, i = (jp >> 1) & 7, sec = jp & 1; return half * 16 + sec * 8 + i; }

struct SrcWin {
  const float* w;
  __device__ __forceinline__ float operator()(int n, int k) const {
    int src;
    if (n < 1024) src = n;
    else if (n < 1536) src = 1056 + (n - 1024);
    else if (n < 1792) src = 1568 + (n - 1536);
    else { const int c = n - 1792;
      if (c < 128) src = 1824 + c;
      else if (c < 160) src = 1952 + rope_unperm(c - 128);
      else if (c < 176) src = 1024 + (c - 160);
      else if (c < 192) src = 1040 + (c - 176);
      else return 0.f; }
    return w[(size_t)k * 1984 + src];
  }
};
struct SrcWup {
  const float *wq, *gq, *wkv, *gkv;
  __device__ __forceinline__ float operator()(int n, int k) const {
    if (n < 768) { if (k >= 256) return 0.f; const int h = n / 96, dp = n % 96; const int d = dp < 64 ? dp : 64 + rope_unperm(dp - 64);
      return wq[(size_t)k * 768 + h * 96 + d] * gq[k]; }
    if (k < 256) return 0.f;
    return wkv[(size_t)(k - 256) * 1024 + (n - 768)] * gkv[k - 256];
  }
};
struct SrcWo { const float* w; __device__ __forceinline__ float operator()(int n, int k) const { return w[(size_t)k * 1024 + n]; } };
__host__ __device__ __forceinline__ void pair_ab(int p, int& a, int& b) { a = p < 3 ? 0 : (p < 5 ? 1 : 2); b = p < 3 ? p + 1 : (p < 5 ? p - 1 : 3); }
struct SrcW1 {
  const float *wg, *wu;
  __device__ __forceinline__ float operator()(int n, int k) const {
    const int bk = n >> 10, r = n & 1023, pnl = r >> 8, rr = r & 255, g = bk / 6, p = bk % 6; int a, b; pair_ab(p, a, b);
    const int e = g * 4 + ((pnl >> 1) ? b : a), hid = (pnl & 1) * 128 + (rr & 127);
    const long delta = (rr < 128) ? 0L : (long)(wu - wg);
    return wg[(long)(((size_t)e * 1024 + k) * 256 + hid) + delta];
  }
};
struct SrcW2 {
  const float* wd;
  __device__ __forceinline__ float operator()(int n, int k) const {
    const int bk = n >> 10, col = n & 1023, g = bk / 6, p = bk % 6; int a, b; pair_ab(p, a, b);
    const int e = g * 4 + ((k >> 8) ? b : a);
    return wd[((size_t)e * 256 + (k & 255)) * 1024 + col];
  }
};
template <class Src> __device__ __forceinline__ void wprep_tile(const Src& S, bf16_t* Wt, int K, int n0, int k0, LAS float* t) {
  const int tid = threadIdx.x;
  { const int nl = tid & 63, kk0 = tid >> 6;
#pragma unroll
    for (int i = 0; i < 8; ++i) { const int kk = kk0 + 8 * i; t[kk * 65 + nl] = S(n0 + nl, k0 + kk); } }
  __syncthreads();
  { const int nl = tid >> 3, ks = (tid & 7) * 8; u32x4 w;
    w.x = cvt_pk(t[(ks + 0) * 65 + nl], t[(ks + 1) * 65 + nl]); w.y = cvt_pk(t[(ks + 2) * 65 + nl], t[(ks + 3) * 65 + nl]);
    w.z = cvt_pk(t[(ks + 4) * 65 + nl], t[(ks + 5) * 65 + nl]); w.w = cvt_pk(t[(ks + 6) * 65 + nl], t[(ks + 7) * 65 + nl]);
    *(u32x4*)(Wt + (size_t)(n0 + nl) * K + k0 + ks) = w; }
  __syncthreads();
}
template <class Src> __device__ __forceinline__ void wprep(const Src& S, bf16_t* Wt, int N, int K, int item0, int nitems_total_before, LAS float* t, int& cursor) {
  const int tk = K / 64, tiles = (N / 64) * tk;
  for (int i = 0; i < tiles; ++i) { const int gi = cursor + i; if (gi % (int)gridDim.x != (int)blockIdx.x) continue; wprep_tile(S, Wt, K, (i / tk) * 64, (i % tk) * 64, t); }
  cursor += tiles; (void)item0; (void)nitems_total_before;
}

__device__ __forceinline__ void phase0(const MP& p, LAS unsigned char* lds) {
  const int tid = threadIdx.x, bid = blockIdx.x, G = gridDim.x;
  unsigned char* ws = p.ws;
  if (bid == 0) { int* cnt = (int*)(ws + WS_CNT); for (int i = tid; i < 4096; i += NTH) cnt[i] = 0; }
  { float* rope = (float*)(ws + WS_ROPE);
    for (int e = bid * NTH + tid; e < 4096 * 16; e += G * NTH) { const int s = e >> 4, a = e & 15, half = a >> 3, i = a & 7;
      const float pos = half ? (float)(s & 63) : (float)(s >> 6); const float inv = powf(10000.f, -(float)i / 8.f); const float ang = pos * inv;
      rope[e * 2] = cosf(ang); rope[e * 2 + 1] = sinf(ang); } }
  { LAS float* sc = (LAS float*)lds;
    LAS float* red = sc + 9 * 1024;
    bool have = false; for (int it = bid; it < 96; it += G) have = true;
    if (have) {
      for (int e = tid; e < 9 * 1024; e += NTH) { const int r = e >> 10, k = e & 1023; const float x = r < 8 ? p.in[I_C][r * 1024 + k] : p.in[I_CCTX][k]; sc[e] = x / (1.f + expf(-x)); }
      __syncthreads();
      for (int it = bid; it < 96; it += G) {
        const int col = it * 64 + (tid & 63), kg = tid >> 6; float acc[9];
#pragma unroll
        for (int r = 0; r < 9; ++r) acc[r] = 0.f;
        const float* w = p.in[I_WADA] + (size_t)(kg * 128) * 6144 + col;
        for (int k = 0; k < 128; ++k) { const float wv = w[(size_t)k * 6144];
#pragma unroll
          for (int r = 0; r < 9; ++r) acc[r] += sc[r * 1024 + kg * 128 + k] * wv; }
#pragma unroll
        for (int r = 0; r < 9; ++r) red[(kg * 9 + r) * 64 + (tid & 63)] = acc[r];
        __syncthreads();
        for (int e = tid; e < 9 * 64; e += NTH) { const int r = e >> 6, c = e & 63; float s = 0.f;
#pragma unroll
          for (int g = 0; g < 8; ++g) s += red[(g * 9 + r) * 64 + c];
          ((float*)(ws + WS_MOD))[r * 6144 + it * 64 + c] = s + p.in[I_BADA][it * 64 + c]; }
        __syncthreads();
      }
    }
    __syncthreads();
  }
  { LAS float* t = (LAS float*)lds; int cursor = 96;
    wprep(SrcWin{p.in[I_WIN]}, (bf16_t*)(ws + WS_WINT), 2048, 1024, 0, 0, t, cursor);
    wprep(SrcWup{p.in[I_WUQ], p.in[I_QNG], p.in[I_WUKV], p.in[I_KVNG]}, (bf16_t*)(ws + WS_WUPT), 1792, 384, 0, 0, t, cursor);
    wprep(SrcWo{p.in[I_WO]}, (bf16_t*)(ws + WS_WOT), 1024, 1024, 0, 0, t, cursor); }
}

__device__ __forceinline__ void phase1(const MP& p) {
  const float* mod = (const float*)(p.ws + WS_MOD); bf16_t* U = (bf16_t*)(p.ws + WS_U);
  const int total = MROWS * 128;
  for (int e = blockIdx.x * NTH + threadIdx.x; e < total; e += gridDim.x * NTH) {
    const int row = e >> 7, c8 = (e & 127) * 8;
    const float* src; const float* m;
    if (row < NLAT) { src = p.in[I_X] + (size_t)row * D; m = mod + (row >> 12) * 6144; } else { src = p.in[I_CTX] + (size_t)(row - NLAT) * D; m = mod + 8 * 6144; }
    const f32x4 x0 = *(const f32x4*)(src + c8), x1 = *(const f32x4*)(src + c8 + 4);
    const f32x4 s0 = *(const f32x4*)(m + c8), s1 = *(const f32x4*)(m + c8 + 4), g0 = *(const f32x4*)(m + 1024 + c8), g1 = *(const f32x4*)(m + 1024 + c8 + 4);
    const f32x4 u0 = x0 * (1.f + g0) + s0, u1 = x1 * (1.f + g1) + s1;
    u32x4 w; w.x = cvt_pk(u0[0], u0[1]); w.y = cvt_pk(u0[2], u0[3]); w.z = cvt_pk(u1[0], u1[1]); w.w = cvt_pk(u1[2], u1[3]);
    *(u32x4*)(U + (size_t)row * D + c8) = w;
  }
}

struct EpiIn {
  static constexpr bool PERM = true, AFTER_DRAIN = false;
  unsigned char* ws;
  __device__ __forceinline__ void operator()(const f32x4 (&acc)[2][2][4][2], const pg8::Unit& u, int wr, int wc, int fr, int fq) const {
    asm volatile("" : "+v"(fr), "+v"(fq));
    const int row0 = u.pm * 256 + wr * 64 + fr; const int pn = u.pn;
#pragma unroll
    for (int bj = 0; bj < 2; ++bj) {
      const int cl = bj * 128 + wc * 32 + 8 * fq;
      bf16_t* base = nullptr; int ld = 0; float* fbase = nullptr; bool skip = false;
      if (pn == 0) { base = (bf16_t*)(ws + WS_QG) + cl; ld = 256; }
      else if (pn == 1) { base = (bf16_t*)(ws + WS_KG) + cl; ld = 256; }
      else if (pn < 4) { base = (bf16_t*)(ws + WS_VG) + (pn - 2) * 256 + cl; ld = 512; }
      else if (pn < 6) { base = (bf16_t*)(ws + WS_RG) + (pn - 4) * 256 + cl; ld = 512; }
      else if (pn == 6) { base = (bf16_t*)(ws + WS_A2) + cl; ld = 384; }
      else { if (cl < 128) { base = (bf16_t*)(ws + WS_A2) + 256 + cl; ld = 384; }
             else if (cl < 160) fbase = (float*)(ws + WS_KR) + (cl - 128);
             else if (cl < 192) fbase = (float*)(ws + WS_GFB) + (cl - 160);
             else skip = true; }
      if (skip) continue;
#pragma unroll
      for (int ai = 0; ai < 2; ++ai)
#pragma unroll
        for (int m = 0; m < 4; ++m) { const int row = row0 + ai * 128 + m * 16; const f32x4 v0 = acc[ai][bj][m][0], v1 = acc[ai][bj][m][1];
          if (base) { u32x4 w; w.x = cvt_pk(v0[0], v0[1]); w.y = cvt_pk(v0[2], v0[3]); w.z = cvt_pk(v1[0], v1[1]); w.w = cvt_pk(v1[2], v1[3]);
            *(u32x4*)(base + (size_t)row * ld) = w; }
          else { *(f32x4*)(fbase + (size_t)row * 32) = v0; *(f32x4*)(fbase + (size_t)row * 32 + 4) = v1; } }
    }
  }
};
__device__ __forceinline__ void phase2(const MP& p, LAS unsigned char* lds) {
  pg8::Gemm g{(const bf16_t*)(p.ws + WS_U), (const bf16_t*)(p.ws + WS_WINT), MROWS, 2048, 1024};
  pg8::StaticOrder S; S.init(MROWS, 2048, gridDim.x, blockIdx.x);
  EpiIn E{p.ws};
  pg8::gemm_phase<EpiIn, pg8::StaticOrder, true, true>(lds, g, S, E);
}

__global__ void bridge1_k(const unsigned char* ws, float* pn, int b) {
  const int r = blockIdx.x; const int gr = grow(b, r);
  const bf16_t* QG = (const bf16_t*)(ws + WS_QG); const bf16_t* KG = (const bf16_t*)(ws + WS_KG); const bf16_t* VG = (const bf16_t*)(ws + WS_VG);
  const bf16_t* RG = (const bf16_t*)(ws + WS_RG); const bf16_t* A2 = (const bf16_t*)(ws + WS_A2); const float* KR = (const float*)(ws + WS_KR); const float* GFB = (const float*)(ws + WS_GFB);
  for (int c = threadIdx.x; c < 1984; c += 256) { float v;
    if (c < 256) v = bf2f(QG[(size_t)gr * 256 + c]);
    else if (c < 512) v = bf2f(KG[(size_t)gr * 256 + c - 256]);
    else if (c < 1024) v = bf2f(VG[(size_t)gr * 512 + c - 512]);
    else if (c < 1056) v = GFB[(size_t)gr * 32 + c - 1024];
    else if (c < 1568) v = bf2f(RG[(size_t)gr * 512 + c - 1056]);
    else if (c < 1824) v = bf2f(A2[(size_t)gr * 384 + c - 1568]);
    else if (c < 1952) v = bf2f(A2[(size_t)gr * 384 + 256 + c - 1824]);
    else { const int j = c - 1952; int jp = 0; for (int q = 0; q < 32; ++q) if (rope_unperm(q) == j) jp = q; v = KR[(size_t)gr * 32 + jp]; }
    pn[(size_t)r * 1984 + c] = v; }
}
}
namespace mk {
__device__ __forceinline__ float logsig_f(float x) { return fminf(x, 0.f) - log1pf(expf(-fabsf(x))); }
__device__ __forceinline__ int chunk_row0(int u) { return u < 512 ? u * 64 : NLAT + (u - 512) * 64; }

__device__ __forceinline__ void phase3(const MP& p, LAS unsigned char* lds) {
  const int tid = threadIdx.x; unsigned char* ws = p.ws;
  const bf16_t* A2 = (const bf16_t*)(ws + WS_A2); const float* KR = (const float*)(ws + WS_KR); const float* GFB = (const float*)(ws + WS_GFB);
  float* RS = (float*)(ws + WS_RS); const float* rope = (const float*)(ws + WS_ROPE); bf16_t* KC = (bf16_t*)(ws + WS_KC);
  float* LGF = (float*)(ws + WS_LGF); float* LGB = (float*)(ws + WS_LGB);
  LAS float* gl = (LAS float*)lds;
  const int gcol = tid & 255, gdir = tid >> 8;
  float gw[16];
  { const float* W = gdir ? p.in[I_WGKB] : p.in[I_WGKF];
#pragma unroll
    for (int i = 0; i < 16; ++i) gw[i] = W[i * 256 + gcol]; }
  const float gbias = (gdir ? p.in[I_BGKB] : p.in[I_BGKF])[gcol];
  for (int u = blockIdx.x; u < 544; u += gridDim.x) {
    const int r0 = chunk_row0(u); const bool lat = u < 512;
    { const int row = tid >> 3, c4 = (tid & 7) * 4; *(LAS f32x4*)(gl + row * 32 + c4) = *(const f32x4*)(GFB + (size_t)(r0 + row) * 32 + c4); }
    { const int row = tid >> 3, seg = tid & 7; const bf16_t* ar = A2 + (size_t)(r0 + row) * 384; float sq = 0.f, skv = 0.f;
#pragma unroll
      for (int i = 0; i < 4; ++i) { const u32x4 w = *(const u32x4*)(ar + seg * 32 + i * 8);
        sq += bflo(w.x) * bflo(w.x) + bfhi(w.x) * bfhi(w.x) + bflo(w.y) * bflo(w.y) + bfhi(w.y) * bfhi(w.y) + bflo(w.z) * bflo(w.z) + bfhi(w.z) * bfhi(w.z) + bflo(w.w) * bflo(w.w) + bfhi(w.w) * bfhi(w.w); }
#pragma unroll
      for (int i = 0; i < 2; ++i) { const u32x4 w = *(const u32x4*)(ar + 256 + seg * 16 + i * 8);
        skv += bflo(w.x) * bflo(w.x) + bfhi(w.x) * bfhi(w.x) + bflo(w.y) * bflo(w.y) + bfhi(w.y) * bfhi(w.y) + bflo(w.z) * bflo(w.z) + bfhi(w.z) * bfhi(w.z) + bflo(w.w) * bflo(w.w) + bfhi(w.w) * bfhi(w.w); }
      sq += __shfl_xor(sq, 1); sq += __shfl_xor(sq, 2); sq += __shfl_xor(sq, 4);
      skv += __shfl_xor(skv, 1); skv += __shfl_xor(skv, 2); skv += __shfl_xor(skv, 4);
      if (seg == 0) { RS[(size_t)(r0 + row) * 2] = rsqrtf(sq * (1.f / 256.f) + EPS); RS[(size_t)(r0 + row) * 2 + 1] = rsqrtf(skv * (1.f / 128.f) + EPS); } }
    { const int row = tid >> 3, h = tid & 7; const int gr = r0 + row; const float* kr = KR + (size_t)gr * 32; const float* rp = rope + (size_t)(gr & 4095) * 32;
      bf16_t* dst = KC + ((size_t)gr * 8 + h) * 96 + 64;
#pragma unroll
      for (int q = 0; q < 4; ++q) { const f32x4 a = *(const f32x4*)(kr + q * 8), b = *(const f32x4*)(kr + q * 8 + 4);
        f32x4 oa = a, ob = b;
        if (lat) { const f32x4 c0 = *(const f32x4*)(rp + q * 8), c1 = *(const f32x4*)(rp + q * 8 + 4);
          oa[0] = a[0] * c0[0] - a[1] * c0[1]; oa[1] = a[1] * c0[0] + a[0] * c0[1]; oa[2] = a[2] * c0[2] - a[3] * c0[3]; oa[3] = a[3] * c0[2] + a[2] * c0[3];
          ob[0] = b[0] * c1[0] - b[1] * c1[1]; ob[1] = b[1] * c1[0] + b[0] * c1[1]; ob[2] = b[2] * c1[2] - b[3] * c1[3]; ob[3] = b[3] * c1[2] + b[2] * c1[3]; }
        u32x4 w; w.x = cvt_pk(oa[0], oa[1]); w.y = cvt_pk(oa[2], oa[3]); w.z = cvt_pk(ob[0], ob[1]); w.w = cvt_pk(ob[2], ob[3]);
        *(u32x4*)(dst + q * 8) = w; } }
    __syncthreads();
    { float run = 0.f; float* out = gdir ? LGB : LGF;
      for (int i = 0; i < 64; ++i) { const int r = gdir ? 63 - i : i; float a = gbias;
#pragma unroll
        for (int j = 0; j < 16; ++j) a += gl[r * 32 + gdir * 16 + j] * gw[j];
        run += logsig_f(a) * (1.f / 16.f);
        out[(size_t)(r0 + r) * 256 + gcol] = run; } }
    __syncthreads();
  }
}

struct EpiUp {
  static constexpr bool PERM = true, AFTER_DRAIN = false;
  unsigned char* ws;
  __device__ __forceinline__ void operator()(const f32x4 (&acc)[2][2][4][2], const pg8::Unit& u, int wr, int wc, int fr, int fq) const {
    asm volatile("" : "+v"(fr), "+v"(fq));
    const unsigned row0 = u.pm * 256 + wr * 64 + fr; const int pn = u.pn;
    if (pn < 3) {
#pragma unroll
      for (int bj = 0; bj < 2; ++bj) {
        const unsigned c = pn * 256 + bj * 128 + wc * 32 + 8 * fq; const unsigned h = c / 96u, dp = c - h * 96u; const bool rot = dp >= 64u;
        const unsigned ro = rot ? dp - 64u : 0u;
#pragma unroll
        for (int ai = 0; ai < 2; ++ai)
#pragma unroll
          for (int m = 0; m < 4; ++m) {
            const unsigned row = row0 + ai * 128 + m * 16;
            if (row < (unsigned)NLAT) {
              const float rs = *(const float*)(ws + (unsigned)(WS_RS + row * 8u)) * QSCALE;
              f32x4 v0 = acc[ai][bj][m][0], v1 = acc[ai][bj][m][1];
              const unsigned roff = (unsigned)WS_ROPE + ((row & 4095u) * 32u + ro) * 4u;
              f32x4 c0 = *(const f32x4*)(ws + roff), c1 = *(const f32x4*)(ws + roff + 16u);
              if (!rot) { c0 = (f32x4){1.f, 0.f, 1.f, 0.f}; c1 = c0; }
              const f32x4 a = v0, b = v1;
              v0[0] = a[0] * c0[0] - a[1] * c0[1]; v0[1] = a[1] * c0[0] + a[0] * c0[1]; v0[2] = a[2] * c0[2] - a[3] * c0[3]; v0[3] = a[3] * c0[2] + a[2] * c0[3];
              v1[0] = b[0] * c1[0] - b[1] * c1[1]; v1[1] = b[1] * c1[0] + b[0] * c1[1]; v1[2] = b[2] * c1[2] - b[3] * c1[3]; v1[3] = b[3] * c1[2] + b[2] * c1[3];
              v0 = v0 * rs; v1 = v1 * rs;
              u32x4 w; w.x = cvt_pk(v0[0], v0[1]); w.y = cvt_pk(v0[2], v0[3]); w.z = cvt_pk(v1[0], v1[1]); w.w = cvt_pk(v1[2], v1[3]);
              *(u32x4*)(ws + (unsigned)(WS_QC + ((row * 8u + h) * 96u + dp) * 2u)) = w;
            }
            asm volatile("" ::: "memory");
          }
      }
    } else {
#pragma unroll
      for (int bj = 0; bj < 2; ++bj) {
        const unsigned c = (pn - 3) * 256 + bj * 128 + wc * 32 + 8 * fq; const unsigned h = c >> 7, d = c & 127u;
        const unsigned dbase = d < 64u ? (unsigned)WS_KC + (h * 96u + d) * 2u : (unsigned)WS_VC + (h * 64u + (d - 64u)) * 2u; const unsigned ldb = d < 64u ? 1536u : 1024u;
#pragma unroll
        for (int ai = 0; ai < 2; ++ai)
#pragma unroll
          for (int m = 0; m < 4; ++m) {
            const unsigned row = row0 + ai * 128 + m * 16; const float rs = *(const float*)(ws + (unsigned)(WS_RS + row * 8u + 4u));
            const f32x4 v0 = acc[ai][bj][m][0] * rs, v1 = acc[ai][bj][m][1] * rs;
            u32x4 w; w.x = cvt_pk(v0[0], v0[1]); w.y = cvt_pk(v0[2], v0[3]); w.z = cvt_pk(v1[0], v1[1]); w.w = cvt_pk(v1[2], v1[3]);
            *(u32x4*)(ws + (dbase + row * ldb)) = w;
            asm volatile("" ::: "memory");
          }
      }
    }
  }
};
__device__ __forceinline__ void phase4_gemm(const MP& p, LAS unsigned char* lds) {
  int K = 384; asm volatile("" : "+s"(K));
  pg8::Gemm g{(const bf16_t*)(p.ws + WS_A2), (const bf16_t*)(p.ws + WS_WUPT), MROWS, 1792, K};
  pg8::StaticOrder S; S.init(MROWS, 1792, gridDim.x, blockIdx.x);
  EpiUp E{p.ws};
  pg8::gemm_phase<EpiUp, pg8::StaticOrder, true, true>(lds, g, S, E);
}

__global__ void bridge2a_k(const unsigned char* ws, float* Qc, float* Kc, float* kv, int b) {
  const int r = blockIdx.x; const int gr = grow(b, r);
  const bf16_t* QC = (const bf16_t*)(ws + WS_QC); const bf16_t* KC = (const bf16_t*)(ws + WS_KC); const bf16_t* VC = (const bf16_t*)(ws + WS_VC);
  for (int e = threadIdx.x; e < 768; e += 256) {
    Kc[(size_t)r * 768 + e] = bf2f(KC[(size_t)gr * 768 + e]);
    if (r < SEQ) Qc[(size_t)r * 768 + e] = bf2f(QC[(size_t)gr * 768 + e]) * (1.f / 1.4426950408889634f) * 9.797958971132712f;
  }
  for (int e = threadIdx.x; e < 512; e += 256) { const int h = e >> 6, d = e & 63; kv[(size_t)r * 1024 + h * 128 + 64 + d] = bf2f(VC[(size_t)gr * 512 + e]); }
}
}
namespace mk {
namespace att {
typedef short s16x4 __attribute__((ext_vector_type(4)));
constexpr int NW = 8, QBLK = 32, KVBLK = 64, NT = 68;
constexpr int KROWB = 208;
constexpr int SHM_K = KVBLK * KROWB;
constexpr int SHM_V = KVBLK * 64 * 2;
constexpr int LDS_V = 0, LDS_K = 2 * SHM_V, LDS_WS = LDS_K + 2 * SHM_K, LDS_ATT = LDS_WS + NW * 64 * 4;
constexpr float THR = 8.f;
#define SBAR() __builtin_amdgcn_sched_barrier(0)
__device__ __forceinline__ int crow(int r, int hi) { return (r & 3) + 8 * (r >> 2) + 4 * hi; }

__device__ __forceinline__ void partialSM(f32x16& p0, f32x16& p1, float& m_reg, float& mn, float& alpha) {
  float pmax = p0[0];
#pragma unroll
  for (int r = 1; r < 16; ++r) pmax = fmaxf(pmax, p0[r]);
#pragma unroll
  for (int r = 0; r < 16; ++r) pmax = fmaxf(pmax, p1[r]);
  { auto rr = __builtin_amdgcn_permlane32_swap(__float_as_uint(pmax), __float_as_uint(pmax), false, false);
    pmax = fmaxf(__uint_as_float(rr[0]), __uint_as_float(rr[1])); }
  if (__builtin_expect(__all(pmax - m_reg <= THR), 1)) { mn = m_reg; alpha = 1.f; }
  else { mn = fmaxf(m_reg, pmax); alpha = __builtin_amdgcn_exp2f(m_reg - mn); m_reg = mn; }
#pragma unroll
  for (int r = 0; r < 16; ++r) p0[r] = p0[r] - mn;
#pragma unroll
  for (int r = 0; r < 16; ++r) p1[r] = p1[r] - mn;
#pragma unroll
  for (int r = 0; r < 16; ++r) p0[r] = __builtin_amdgcn_exp2f(p0[r]);
}
__device__ __forceinline__ void finishSM(f32x16& p0, f32x16& p1, float alpha, float& l_reg, bf16x8& pa0, bf16x8& pa1, bf16x8& pa2, bf16x8& pa3) {
#pragma unroll
  for (int r = 0; r < 16; ++r) p1[r] = __builtin_amdgcn_exp2f(p1[r]);
  float ps = 0;
#pragma unroll
  for (int r = 0; r < 16; ++r) ps += p0[r];
#pragma unroll
  for (int r = 0; r < 16; ++r) ps += p1[r];
  { auto rr = __builtin_amdgcn_permlane32_swap(__float_as_uint(ps), __float_as_uint(ps), false, false);
    ps = __uint_as_float(rr[0]) + __uint_as_float(rr[1]); }
  l_reg = l_reg * alpha + ps;
#define PK4(P, BASE, OUT) do { unsigned a0 = cvt_pk(P[BASE + 0], P[BASE + 1]), a1 = cvt_pk(P[BASE + 2], P[BASE + 3]);   \
    unsigned b0 = cvt_pk(P[BASE + 4], P[BASE + 5]), b1 = cvt_pk(P[BASE + 6], P[BASE + 7]);                              \
    auto r0 = __builtin_amdgcn_permlane32_swap(a0, b0, false, false); auto r1 = __builtin_amdgcn_permlane32_swap(a1, b1, false, false); \
    u32x4 w = {r0[0], r1[0], r0[1], r1[1]}; OUT = __builtin_bit_cast(bf16x8, w); } while (0)
  PK4(p0, 0, pa0); PK4(p0, 8, pa1); PK4(p1, 0, pa2); PK4(p1, 8, pa3);
#undef PK4
}
__device__ __forceinline__ void qkt(f32x16& p0, f32x16& p1, const LAS unsigned char* Ks, const bf16x8* qr, int r32, int hi) {
  p0 = f32x16{}; p1 = f32x16{};
#pragma unroll
  for (int d0 = 0; d0 < 6; ++d0) { const int cb = (d0 * 16 + hi * 8) * 2;
    const bf16x8 b0 = *(const LAS bf16x8*)(Ks + r32 * KROWB + cb);
    const bf16x8 b1 = *(const LAS bf16x8*)(Ks + (32 + r32) * KROWB + cb);
    p0 = __builtin_amdgcn_mfma_f32_32x32x16_bf16(b0, qr[d0], p0, 0, 0, 0);
    p1 = __builtin_amdgcn_mfma_f32_32x32x16_bf16(b1, qr[d0], p1, 0, 0, 0); }
}
__device__ __forceinline__ int v_st(int k, int c) { const int kk = (k & ~0xC) | ((k & 4) << 1) | ((k & 8) >> 1); return ((kk >> 3) * 2 + (c >> 5)) * 512 + ((kk & 7) * 32 + (c & 31)) * 2; }
__device__ __forceinline__ int v_rd_base(int lane) { return ((lane & 3) << 3) | (((lane >> 2) & 3) << 6) | (((lane >> 4) & 1) << 5) | (((lane >> 5) & 1) << 8); }
constexpr int v_rd_off(int d0, int ks, int half) { return d0 * 512 + ks * 2048 + half * 1024; }
template <int OFF> __device__ __forceinline__ s16x4 tr_read(int vb) {
  s16x4 r; asm volatile("ds_read_b64_tr_b16 %0, %1 offset:%2" : "=&v"(r) : "v"(vb), "i"(OFF) : "memory"); return r;
}
template <int D0> __device__ __forceinline__ void pv_one(f32x16& od, int vb, bf16x8 pa0, bf16x8 pa1, bf16x8 pa2, bf16x8 pa3) {
  const s16x4 l0 = tr_read<v_rd_off(D0, 0, 0)>(vb), h0 = tr_read<v_rd_off(D0, 0, 1)>(vb), l1 = tr_read<v_rd_off(D0, 1, 0)>(vb), h1 = tr_read<v_rd_off(D0, 1, 1)>(vb);
  const s16x4 l2 = tr_read<v_rd_off(D0, 2, 0)>(vb), h2 = tr_read<v_rd_off(D0, 2, 1)>(vb), l3 = tr_read<v_rd_off(D0, 3, 0)>(vb), h3 = tr_read<v_rd_off(D0, 3, 1)>(vb);
  asm volatile("s_waitcnt lgkmcnt(0)" ::: "memory"); SBAR();
#define PK(L, H) (bf16x8){L[0], L[1], L[2], L[3], H[0], H[1], H[2], H[3]}
  od = __builtin_amdgcn_mfma_f32_32x32x16_bf16(pa0, PK(l0, h0), od, 0, 0, 0);
  od = __builtin_amdgcn_mfma_f32_32x32x16_bf16(pa1, PK(l1, h1), od, 0, 0, 0);
  od = __builtin_amdgcn_mfma_f32_32x32x16_bf16(pa2, PK(l2, h2), od, 0, 0, 0);
  od = __builtin_amdgcn_mfma_f32_32x32x16_bf16(pa3, PK(l3, h3), od, 0, 0, 0);
#undef PK
}
__device__ __forceinline__ void pv_d0(f32x16* o, int vb, bf16x8 pa0, bf16x8 pa1, bf16x8 pa2, bf16x8 pa3) {
  pv_one<0>(o[0], vb, pa0, pa1, pa2, pa3); pv_one<1>(o[1], vb, pa0, pa1, pa2, pa3);
}

__device__ __forceinline__ void attn_unit(const bf16_t* __restrict__ QC, const bf16_t* __restrict__ KC, const bf16_t* __restrict__ VC, bf16_t* __restrict__ MIX,
                                          int b, int h, int qb, LAS unsigned char* lds) {
  const int tid = threadIdx.x, wid = tid >> 6, lane = tid & 63, r32 = lane & 31, hi = lane >> 5;
  LAS unsigned char* V_lds = lds + LDS_V; LAS unsigned char* K_lds = lds + LDS_K;
  LAS float* wsf = (LAS float*)(lds + LDS_WS) + wid * 64; LAS float* li_l = wsf; LAS float* al_l = wsf + 32;
  float m_reg = -1e30f, l_reg = 0; f32x16 o[2] = {}; bf16x8 qr[6];
  const int qrow = b * SEQ + qb * 256 + wid * QBLK + r32;
  const bf16_t* Qw = QC + ((size_t)qrow * 8 + h) * 96 + hi * 8;
#pragma unroll
  for (int d0 = 0; d0 < 6; ++d0) qr[d0] = *(const bf16x8*)(Qw + d0 * 16);
  const int sr = tid >> 3, sc = (tid & 7) * 8, vst = v_st(sr, sc);
  const int k0r = tid / 12, k0c = tid - k0r * 12; const int id1 = 512 + (tid & 255); const int k1r = id1 / 12, k1c = id1 - k1r * 12; const bool w1 = tid < 256;
  const int kst0 = k0r * KROWB + k0c * 16, kst1 = k1r * KROWB + k1c * 16;
  const int vb0 = (int)(unsigned)(size_t)V_lds + v_rd_base(lane);
  const bf16_t* Kh = KC + (size_t)h * 96; const bf16_t* Vh = VC + (size_t)h * 64;
  struct { bf16x8 vs, ks0, ks1; } sr_[2];
#define TROW(j) ((j) < 64 ? b * SEQ + (j) * 64 : NLAT + b * CTXL + ((j) - 64) * 64)
#define SLOAD(i, j) do { const int tr_ = TROW(j); sr_[i].vs = *(const bf16x8*)(Vh + (size_t)(tr_ + sr) * 512 + sc); \
    sr_[i].ks0 = *(const bf16x8*)(Kh + (size_t)(tr_ + k0r) * 768 + k0c * 8); sr_[i].ks1 = *(const bf16x8*)(Kh + (size_t)(tr_ + k1r) * 768 + k1c * 8); } while (0)
#define SWRITE(bb, i) do { *(LAS bf16x8*)(V_lds + (bb) * SHM_V + vst) = sr_[i].vs; *(LAS bf16x8*)(K_lds + (bb) * SHM_K + kst0) = sr_[i].ks0; \
    if (w1) *(LAS bf16x8*)(K_lds + (bb) * SHM_K + kst1) = sr_[i].ks1; } while (0)
#define SWAIT() asm volatile("s_waitcnt vmcnt(3)" ::: "memory")
#define RESC(a) do { if (__any((a) < 1.f)) { if (hi == 0) al_l[r32] = (a); asm volatile("s_waitcnt lgkmcnt(0)" ::: "memory"); \
    _Pragma("unroll") for (int d = 0; d < 2; ++d) _Pragma("unroll") for (int r = 0; r < 16; ++r) o[d][r] *= al_l[crow(r, hi)]; } } while (0)
  f32x16 pA0, pA1, pB0, pB1; float mnA, mnB, alA, alB; bf16x8 pa0, pa1, pa2, pa3;
  constexpr int SE = 0, SO = 1;
  SLOAD(SE, 0); asm volatile("s_waitcnt vmcnt(0)" ::: "memory"); SWRITE(0, SE); __syncthreads();
  qkt(pA0, pA1, K_lds, qr, r32, hi); partialSM(pA0, pA1, m_reg, mnA, alA);
  SLOAD(SO, 1); SLOAD(SE, 2);
  SWAIT(); SWRITE(1, SO); __syncthreads();
  for (int j = 1; j + 1 < NT; j += 2) {
    SBAR(); qkt(pB0, pB1, K_lds + SHM_K, qr, r32, hi);
    finishSM(pA0, pA1, alA, l_reg, pa0, pa1, pa2, pa3); SBAR();
    SLOAD(SO, j + 2); SBAR();
    pv_d0(o, vb0, pa0, pa1, pa2, pa3); partialSM(pB0, pB1, m_reg, mnB, alB);
    __syncthreads(); SWAIT(); SWRITE(0, SE);
    RESC(alB); __syncthreads();
    SBAR(); qkt(pA0, pA1, K_lds, qr, r32, hi);
    finishSM(pB0, pB1, alB, l_reg, pa0, pa1, pa2, pa3); SBAR();
    if (j + 3 < NT) SLOAD(SE, j + 3); SBAR();
    pv_d0(o, vb0 + SHM_V, pa0, pa1, pa2, pa3); partialSM(pA0, pA1, m_reg, mnA, alA);
    __syncthreads(); SWAIT(); SWRITE(1, SO);
    RESC(alA); __syncthreads();
  }
  SBAR(); qkt(pB0, pB1, K_lds + SHM_K, qr, r32, hi);
  finishSM(pA0, pA1, alA, l_reg, pa0, pa1, pa2, pa3); SBAR();
  pv_d0(o, vb0, pa0, pa1, pa2, pa3); partialSM(pB0, pB1, m_reg, mnB, alB);
  __syncthreads(); RESC(alB);
  finishSM(pB0, pB1, alB, l_reg, pa0, pa1, pa2, pa3); SBAR();
  pv_d0(o, vb0 + SHM_V, pa0, pa1, pa2, pa3);
  if (hi == 0) li_l[r32] = l_reg; asm volatile("s_waitcnt lgkmcnt(0)" ::: "memory");
  bf16_t* Ow = MIX + (size_t)(b * SEQ + qb * 256 + wid * QBLK) * 1024 + 512 + h * 64;
#pragma unroll
  for (int r = 0; r < 16; ++r) { const int orow = crow(r, hi); const float rl = __builtin_amdgcn_rcpf(li_l[orow]);
#pragma unroll
    for (int d0 = 0; d0 < 2; ++d0) { const float v = o[d0][r] * rl; const unsigned w = cvt_pk(v, v); Ow[(size_t)orow * 1024 + d0 * 32 + r32] = (bf16_t)(w & 0xffffu); } }
  __syncthreads();
#undef TROW
#undef SLOAD
#undef SWRITE
#undef SWAIT
#undef RESC
}
}

__device__ __forceinline__ void phase5_attn(const MP& p, LAS unsigned char* lds) {
  const bf16_t* QC = (const bf16_t*)(p.ws + WS_QC); const bf16_t* KC = (const bf16_t*)(p.ws + WS_KC); const bf16_t* VC = (const bf16_t*)(p.ws + WS_VC);
  bf16_t* MIX = (bf16_t*)(p.ws + WS_MIX);
  const int bid = blockIdx.x, G = gridDim.x;
  if (G == 256) {
    const int xcd = bid & 7, slot = bid >> 3, bhl = slot >> 4, qb = slot & 15;
    for (int i = 0; i < 4; ++i) { const int bh = (i * 2 + bhl) * 8 + xcd; att::attn_unit(QC, KC, VC, MIX, bh >> 3, bh & 7, qb, lds); }
  } else {
    for (int u = bid; u < 1024; u += G) { const int bh = u >> 4, qb = u & 15; att::attn_unit(QC, KC, VC, MIX, bh >> 3, bh & 7, qb, lds); }
  }
}

__global__ void bridge2b_k(const unsigned char* ws, float* mix, int b, int c0, int c1) {
  const int r = blockIdx.x; const bf16_t* MIX = (const bf16_t*)(ws + WS_MIX);
  for (int c = c0 + threadIdx.x; c < c1; c += 256) mix[(size_t)r * 1024 + c] = bf2f(MIX[(size_t)(b * SEQ + r) * 1024 + c]);
}
}
namespace mk {
namespace gla {
constexpr int RS144 = 144;
constexpr int L_VT = 0;
constexpr int L_K1 = 18432, L_K2 = L_K1 + 9216;
constexpr int L_O = L_K2 + 9216;
constexpr int OST = 132;
__device__ __forceinline__ int crow(int r, int hi) { return (r & 3) + 8 * (r >> 2) + 4 * hi; }
__device__ __forceinline__ int cid_row0(int b, int cid) { return cid < 4 ? NLAT + b * CTXL + cid * 64 : b * SEQ + (cid - 4) * 64; }
__device__ __forceinline__ size_t ds_off(int b, int h, int dir, int cid) { return ((size_t)(((b * 4 + h) * 2 + dir) * 68 + cid)) * 8192; }

__device__ __forceinline__ void stage_vt(const bf16_t* VG, int row0, int h, LAS unsigned char* vt) {
  const int tid = threadIdx.x;
#pragma unroll
  for (int i = 0; i < 2; ++i) { const int ch = tid + i * 512, j = ch >> 4, v0 = (ch & 15) * 8;
    const u32x4 w = *(const u32x4*)(VG + (size_t)(row0 + j) * 512 + h * 128 + v0);
    LAS unsigned short* d = (LAS unsigned short*)(vt + v0 * RS144 + j * 2);
    d[0 * 72] = (unsigned short)(w.x & 0xffff); d[1 * 72] = (unsigned short)(w.x >> 16); d[2 * 72] = (unsigned short)(w.y & 0xffff); d[3 * 72] = (unsigned short)(w.y >> 16);
    d[4 * 72] = (unsigned short)(w.z & 0xffff); d[5 * 72] = (unsigned short)(w.z >> 16); d[6 * 72] = (unsigned short)(w.w & 0xffff); d[7 * 72] = (unsigned short)(w.w >> 16); }
}

__device__ __forceinline__ void stage1_unit(const MP& p, int b, int h, int cid, LAS unsigned char* lds) {
  const int tid = threadIdx.x, wid = tid >> 6, lane = tid & 63, r32 = lane & 31, hi = lane >> 5;
  unsigned char* ws = p.ws; const bf16_t* KG = (const bf16_t*)(ws + WS_KG); const bf16_t* VG = (const bf16_t*)(ws + WS_VG);
  const float* LGF = (const float*)(ws + WS_LGF); const float* LGB = (const float*)(ws + WS_LGB); bf16_t* DS = (bf16_t*)(ws + WS_DS);
  const int row0 = cid_row0(b, cid);
  stage_vt(VG, row0, h, lds + L_VT);
  { const int j = tid >> 3, k0 = (tid & 7) * 8; const u32x4 kw = *(const u32x4*)(KG + (size_t)(row0 + j) * 256 + h * 64 + k0);
    const float* bf = LGF + (size_t)(row0 + j) * 256 + h * 64 + k0; const float* bfe = LGF + (size_t)(row0 + 63) * 256 + h * 64 + k0;
    const float* bb = LGB + (size_t)(row0 + j) * 256 + h * 64 + k0; const float* bbe = LGB + (size_t)row0 * 256 + h * 64 + k0;
    const f32x4 f0 = *(const f32x4*)bf, f1 = *(const f32x4*)(bf + 4), fe0 = *(const f32x4*)bfe, fe1 = *(const f32x4*)(bfe + 4);
    const f32x4 g0 = *(const f32x4*)bb, g1 = *(const f32x4*)(bb + 4), ge0 = *(const f32x4*)bbe, ge1 = *(const f32x4*)(bbe + 4);
    float kv[8] = {bflo(kw.x), bfhi(kw.x), bflo(kw.y), bfhi(kw.y), bflo(kw.z), bfhi(kw.z), bflo(kw.w), bfhi(kw.w)};
    float ef[8] = {fe0[0] - f0[0], fe0[1] - f0[1], fe0[2] - f0[2], fe0[3] - f0[3], fe1[0] - f1[0], fe1[1] - f1[1], fe1[2] - f1[2], fe1[3] - f1[3]};
    float eb[8] = {ge0[0] - g0[0], ge0[1] - g0[1], ge0[2] - g0[2], ge0[3] - g0[3], ge1[0] - g1[0], ge1[1] - g1[1], ge1[2] - g1[2], ge1[3] - g1[3]};
    LAS unsigned short* d1 = (LAS unsigned short*)(lds + L_K1 + k0 * RS144 + j * 2); LAS unsigned short* d2 = (LAS unsigned short*)(lds + L_K2 + k0 * RS144 + j * 2);
#pragma unroll
    for (int i = 0; i < 8; ++i) { const float a = kv[i] * __expf(ef[i]), c = kv[i] * __expf(eb[i]);
      d1[i * 72] = (unsigned short)(cvt_pk(a, a) & 0xffff); d2[i * 72] = (unsigned short)(cvt_pk(c, c) & 0xffff); } }
  __syncthreads();
  { const int dir = wid >> 2, mt = wid & 3;
    const LAS unsigned char* vt = lds + L_VT + (mt * 32 + r32) * RS144 + hi * 16; const LAS unsigned char* kd = lds + (dir ? L_K2 : L_K1) + r32 * RS144 + hi * 16;
    f32x16 acc0 = {}, acc1 = {};
#pragma unroll
    for (int s = 0; s < 4; ++s) { const bf16x8 a = *(const LAS bf16x8*)(vt + s * 32);
      const bf16x8 b0 = *(const LAS bf16x8*)(kd + s * 32), b1 = *(const LAS bf16x8*)(kd + 32 * RS144 + s * 32);
      acc0 = __builtin_amdgcn_mfma_f32_32x32x16_bf16(a, b0, acc0, 0, 0, 0); acc1 = __builtin_amdgcn_mfma_f32_32x32x16_bf16(a, b1, acc1, 0, 0, 0); }
    bf16_t* out = DS + ds_off(b, h, dir, cid);
#pragma unroll
    for (int r = 0; r < 16; ++r) { const int v = mt * 32 + crow(r, hi);
      out[v * 64 + r32] = (bf16_t)(cvt_pk(acc0[r], acc0[r]) & 0xffff); out[v * 64 + 32 + r32] = (bf16_t)(cvt_pk(acc1[r], acc1[r]) & 0xffff); } }
  __syncthreads();
}
__device__ __forceinline__ void stage1(const MP& p, LAS unsigned char* lds) {
  for (int u = blockIdx.x; u < 8 * 4 * 68; u += gridDim.x) { const int cid = u % 68, bh = u / 68; stage1_unit(p, bh >> 2, bh & 3, cid, lds); }
}

__device__ __forceinline__ void stage2(const MP& p) {
  unsigned char* ws = p.ws; const float* LGF = (const float*)(ws + WS_LGF); const float* LGB = (const float*)(ws + WS_LGB); bf16_t* DS = (bf16_t*)(ws + WS_DS);
  for (int e = blockIdx.x * NTH + threadIdx.x; e < 131072; e += gridDim.x * NTH) {
    const int k4 = (e & 15) * 4, v = (e >> 4) & 127, seq = e >> 11, dir = seq & 1, h = (seq >> 1) & 3, b = seq >> 3;
    const float* LG = dir ? LGB : LGF;
    float s0 = 0.f, s1 = 0.f, s2 = 0.f, s3 = 0.f;
    for (int n0 = 0; n0 < 68; n0 += 4) {
      u32x2 dsv[4]; f32x4 lg[4]; bf16_t* ptr[4];
#pragma unroll
      for (int i = 0; i < 4; ++i) { const int n = n0 + i; const int cid = dir ? (n < 4 ? 3 - n : 71 - n) : n;
        const int row0 = cid_row0(b, cid); ptr[i] = DS + ds_off(b, h, dir, cid) + v * 64 + k4;
        dsv[i] = *(const u32x2*)ptr[i]; lg[i] = *(const f32x4*)(LG + (size_t)(row0 + (dir ? 0 : 63)) * 256 + h * 64 + k4); }
#pragma unroll
      for (int i = 0; i < 4; ++i) { u32x2 o; o.x = cvt_pk(s0, s1); o.y = cvt_pk(s2, s3); *(u32x2*)ptr[i] = o;
        s0 = __expf(lg[i][0]) * s0 + bflo(dsv[i].x); s1 = __expf(lg[i][1]) * s1 + bfhi(dsv[i].x); s2 = __expf(lg[i][2]) * s2 + bflo(dsv[i].y); s3 = __expf(lg[i][3]) * s3 + bfhi(dsv[i].y); }
    }
  }
}

__device__ __forceinline__ void stage3_unit(const MP& p, int b, int h, int c, LAS unsigned char* lds) {
  const int tid = threadIdx.x, wid = tid >> 6, lane = tid & 63, r32 = lane & 31, hi = lane >> 5;
  unsigned char* ws = p.ws; const bf16_t* QG = (const bf16_t*)(ws + WS_QG); const bf16_t* KG = (const bf16_t*)(ws + WS_KG); const bf16_t* VG = (const bf16_t*)(ws + WS_VG);
  const bf16_t* RG = (const bf16_t*)(ws + WS_RG); const float* LGF = (const float*)(ws + WS_LGF); const float* LGB = (const float*)(ws + WS_LGB);
  const bf16_t* DS = (const bf16_t*)(ws + WS_DS); bf16_t* MIX = (bf16_t*)(ws + WS_MIX);
  const int row0 = b * SEQ + c * 64, cid = c + 4;
  stage_vt(VG, row0, h, lds + L_VT);
  { const int j = tid >> 3, k0 = (tid & 7) * 8; const u32x4 kw = *(const u32x4*)(KG + (size_t)(row0 + j) * 256 + h * 64 + k0);
    const float* bf = LGF + (size_t)(row0 + j) * 256 + h * 64 + k0; const float* bb = LGB + (size_t)(row0 + j) * 256 + h * 64 + k0;
    const f32x4 f0 = *(const f32x4*)bf, f1 = *(const f32x4*)(bf + 4), g0 = *(const f32x4*)bb, g1 = *(const f32x4*)(bb + 4);
    float kv[8] = {bflo(kw.x), bfhi(kw.x), bflo(kw.y), bfhi(kw.y), bflo(kw.z), bfhi(kw.z), bflo(kw.w), bfhi(kw.w)};
    float ef[8] = {f0[0], f0[1], f0[2], f0[3], f1[0], f1[1], f1[2], f1[3]}; float eb[8] = {g0[0], g0[1], g0[2], g0[3], g1[0], g1[1], g1[2], g1[3]};
    float a[8], cc[8];
#pragma unroll
    for (int i = 0; i < 8; ++i) { a[i] = kv[i] * __expf(-ef[i]); cc[i] = kv[i] * __expf(-eb[i]); }
    u32x4 w1, w2; w1.x = cvt_pk(a[0], a[1]); w1.y = cvt_pk(a[2], a[3]); w1.z = cvt_pk(a[4], a[5]); w1.w = cvt_pk(a[6], a[7]);
    w2.x = cvt_pk(cc[0], cc[1]); w2.y = cvt_pk(cc[2], cc[3]); w2.z = cvt_pk(cc[4], cc[5]); w2.w = cvt_pk(cc[6], cc[7]);
    *(LAS u32x4*)(lds + L_K1 + j * RS144 + k0 * 2) = w1; *(LAS u32x4*)(lds + L_K2 + j * RS144 + k0 * 2) = w2; }
  __syncthreads();
  { const int dir = wid >> 2, half = (wid >> 1) & 1, vh = wid & 1; const int i = half * 32 + r32;
    bf16x8 qr[4];
    { const bf16_t* qp = QG + (size_t)(row0 + i) * 256 + h * 64 + hi * 8; const float* bp = (dir ? LGB : LGF) + (size_t)(row0 + i) * 256 + h * 64 + hi * 8;
#pragma unroll
      for (int s = 0; s < 4; ++s) { const u32x4 qw = *(const u32x4*)(qp + s * 16); const f32x4 b0 = *(const f32x4*)(bp + s * 16), b1 = *(const f32x4*)(bp + s * 16 + 4);
        u32x4 w; w.x = cvt_pk(bflo(qw.x) * __expf(b0[0]) * 0.125f, bfhi(qw.x) * __expf(b0[1]) * 0.125f); w.y = cvt_pk(bflo(qw.y) * __expf(b0[2]) * 0.125f, bfhi(qw.y) * __expf(b0[3]) * 0.125f);
        w.z = cvt_pk(bflo(qw.z) * __expf(b1[0]) * 0.125f, bfhi(qw.z) * __expf(b1[1]) * 0.125f); w.w = cvt_pk(bflo(qw.w) * __expf(b1[2]) * 0.125f, bfhi(qw.w) * __expf(b1[3]) * 0.125f);
        qr[s] = __builtin_bit_cast(bf16x8, w); } }
    f32x16 p0 = {}, p1 = {};
    { const LAS unsigned char* ke = lds + (dir ? L_K2 : L_K1) + r32 * RS144 + hi * 16;
#pragma unroll
      for (int s = 0; s < 4; ++s) { const bf16x8 k0 = *(const LAS bf16x8*)(ke + s * 32), k1 = *(const LAS bf16x8*)(ke + 32 * RS144 + s * 32);
        p0 = __builtin_amdgcn_mfma_f32_32x32x16_bf16(k0, qr[s], p0, 0, 0, 0); p1 = __builtin_amdgcn_mfma_f32_32x32x16_bf16(k1, qr[s], p1, 0, 0, 0); } }
#pragma unroll
    for (int r = 0; r < 16; ++r) { const int j0 = crow(r, hi), j1 = 32 + j0;
      const bool k0 = dir ? (j0 >= i) : (j0 <= i), k1 = dir ? (j1 >= i) : (j1 <= i);
      p0[r] = k0 ? p0[r] : 0.f; p1[r] = k1 ? p1[r] : 0.f; }
    bf16x8 pa0, pa1, pa2, pa3;
#define PK4(P, BASE, OUT) do { unsigned a0 = cvt_pk(P[BASE + 0], P[BASE + 1]), a1 = cvt_pk(P[BASE + 2], P[BASE + 3]);   \
    unsigned b0 = cvt_pk(P[BASE + 4], P[BASE + 5]), b1 = cvt_pk(P[BASE + 6], P[BASE + 7]);                              \
    auto r0 = __builtin_amdgcn_permlane32_swap(a0, b0, false, false); auto r1 = __builtin_amdgcn_permlane32_swap(a1, b1, false, false); \
    u32x4 w = {r0[0], r1[0], r0[1], r1[1]}; OUT = __builtin_bit_cast(bf16x8, w); } while (0)
    PK4(p0, 0, pa0); PK4(p0, 8, pa1); PK4(p1, 0, pa2); PK4(p1, 8, pa3);
#undef PK4
    f32x16 o[2] = {};
    const bf16_t* sp = DS + ds_off(b, h, dir, cid);
#pragma unroll
    for (int d0 = 0; d0 < 2; ++d0) { const int v = vh * 64 + d0 * 32 + r32;
      const LAS unsigned char* vt = lds + L_VT + v * RS144 + hi * 16; const bf16_t* sv = sp + v * 64 + hi * 8;
      const bf16x8 v0 = *(const LAS bf16x8*)(vt), v1 = *(const LAS bf16x8*)(vt + 32), v2 = *(const LAS bf16x8*)(vt + 64), v3 = *(const LAS bf16x8*)(vt + 96);
      const bf16x8 s0 = *(const bf16x8*)(sv), s1 = *(const bf16x8*)(sv + 16), s2 = *(const bf16x8*)(sv + 32), s3 = *(const bf16x8*)(sv + 48);
      o[d0] = __builtin_amdgcn_mfma_f32_32x32x16_bf16(pa0, v0, o[d0], 0, 0, 0); o[d0] = __builtin_amdgcn_mfma_f32_32x32x16_bf16(pa1, v1, o[d0], 0, 0, 0);
      o[d0] = __builtin_amdgcn_mfma_f32_32x32x16_bf16(pa2, v2, o[d0], 0, 0, 0); o[d0] = __builtin_amdgcn_mfma_f32_32x32x16_bf16(pa3, v3, o[d0], 0, 0, 0);
      o[d0] = __builtin_amdgcn_mfma_f32_32x32x16_bf16(qr[0], s0, o[d0], 0, 0, 0); o[d0] = __builtin_amdgcn_mfma_f32_32x32x16_bf16(qr[1], s1, o[d0], 0, 0, 0);
      o[d0] = __builtin_amdgcn_mfma_f32_32x32x16_bf16(qr[2], s2, o[d0], 0, 0, 0); o[d0] = __builtin_amdgcn_mfma_f32_32x32x16_bf16(qr[3], s3, o[d0], 0, 0, 0); }
    LAS float* ob = (LAS float*)(lds + L_O) + dir * 64 * OST;
#pragma unroll
    for (int r = 0; r < 16; ++r) { const int row = half * 32 + crow(r, hi);
      ob[row * OST + vh * 64 + r32] = o[0][r]; ob[row * OST + vh * 64 + 32 + r32] = o[1][r]; } }
  __syncthreads();
  { const int row = tid >> 3, seg = tid & 7; const LAS float* of = (const LAS float*)(lds + L_O) + row * OST + seg * 16; const LAS float* obk = of + 64 * OST;
    float x[16]; float sq = 0.f;
#pragma unroll
    for (int q = 0; q < 4; ++q) { const f32x4 a = *(const LAS f32x4*)(of + q * 4), bq = *(const LAS f32x4*)(obk + q * 4);
#pragma unroll
      for (int t = 0; t < 4; ++t) { x[q * 4 + t] = a[t] + bq[t]; sq += x[q * 4 + t] * x[q * 4 + t]; } }
    sq += __shfl_xor(sq, 1); sq += __shfl_xor(sq, 2); sq += __shfl_xor(sq, 4);
    const float rstd = rsqrtf(sq * (1.f / 128.f) + EPS);
    const bf16_t* rp = RG + (size_t)(row0 + row) * 512 + h * 128 + seg * 16; const float* gp = p.in[I_GLAG] + seg * 16;
    const u32x4 r0 = *(const u32x4*)rp, r1 = *(const u32x4*)(rp + 8);
    const float rr[16] = {bflo(r0.x), bfhi(r0.x), bflo(r0.y), bfhi(r0.y), bflo(r0.z), bfhi(r0.z), bflo(r0.w), bfhi(r0.w), bflo(r1.x), bfhi(r1.x), bflo(r1.y), bfhi(r1.y), bflo(r1.z), bfhi(r1.z), bflo(r1.w), bfhi(r1.w)};
    float y[16];
#pragma unroll
    for (int t = 0; t < 16; ++t) y[t] = x[t] * rstd * gp[t] * (rr[t] / (1.f + __expf(-rr[t])));
    u32x4 w0, w1; w0.x = cvt_pk(y[0], y[1]); w0.y = cvt_pk(y[2], y[3]); w0.z = cvt_pk(y[4], y[5]); w0.w = cvt_pk(y[6], y[7]);
    w1.x = cvt_pk(y[8], y[9]); w1.y = cvt_pk(y[10], y[11]); w1.z = cvt_pk(y[12], y[13]); w1.w = cvt_pk(y[14], y[15]);
    bf16_t* dst = MIX + (size_t)(row0 + row) * 1024 + h * 128 + seg * 16; *(u32x4*)dst = w0; *(u32x4*)(dst + 8) = w1; }
  __syncthreads();
}
__device__ __forceinline__ void stage3(const MP& p, LAS unsigned char* lds) {
  for (int u = blockIdx.x; u < 8 * 4 * 64; u += gridDim.x) { const int c = u & 63, bh = u >> 6; stage3_unit(p, bh >> 2, bh & 3, c, lds); }
}
}
}
namespace mk {
constexpr int CW_NT = 32, CW_TB = 64;
constexpr int MAXT = 152;

__device__ __forceinline__ void prep_expert_weights(const MP& p, LAS unsigned char* lds) {
  LAS float* t = (LAS float*)lds; int cursor = 0;
  wprep(SrcW1{p.in[I_WEG], p.in[I_WEU]}, (bf16_t*)(p.ws + WS_W1T), 24 * 1024, 1024, 0, 0, t, cursor);
  wprep(SrcW2{p.in[I_WED]}, (bf16_t*)(p.ws + WS_W2T), 24 * 1024, 512, 0, 0, t, cursor);
}

struct EpiOut {
  static constexpr bool PERM = false, AFTER_DRAIN = false;
  const float* x; float* out; unsigned char* ws;
  __device__ __forceinline__ void operator()(const f32x4 (&acc)[2][2][4][2], const pg8::Unit& u, int wr, int wc, int fr, int fq) const {
    asm volatile("" : "+v"(fr), "+v"(fq));
    const unsigned row0 = u.pm * 256 + wr * 64 + fr; const unsigned col0 = u.pn * 256 + wc * 32 + 4 * fq; const unsigned b = (u.pm * 256) >> 12;
    f32x4 gt[2][2];
#pragma unroll
    for (int bj = 0; bj < 2; ++bj)
#pragma unroll
      for (int n = 0; n < 2; ++n) gt[bj][n] = *(const f32x4*)(ws + (unsigned)(WS_MOD + (b * 6144u + 2048u + col0 + bj * 128 + n * 16) * 4u));
#pragma unroll
    for (int ai = 0; ai < 2; ++ai)
#pragma unroll
      for (int m = 0; m < 4; ++m) {
        const unsigned row = row0 + ai * 128 + m * 16; const unsigned eo = row * 1024u + col0; float s = 0.f, q = 0.f;
#pragma unroll
        for (int bj = 0; bj < 2; ++bj)
#pragma unroll
          for (int n = 0; n < 2; ++n) { const f32x4 xv = *(const f32x4*)(x + eo + bj * 128 + n * 16); const f32x4 z = xv * ALPHA + gt[bj][n] * acc[ai][bj][m][n];
            *(f32x4*)(out + eo + bj * 128 + n * 16) = z; s += (z[0] + z[1]) + (z[2] + z[3]); q += (z[0] * z[0] + z[1] * z[1]) + (z[2] * z[2] + z[3] * z[3]); }
        s += __shfl_xor(s, 16); s += __shfl_xor(s, 32); q += __shfl_xor(q, 16); q += __shfl_xor(q, 32);
        if (fq == 0) { f32x2 st = {s, q}; *(f32x2*)(ws + (unsigned)(WS_ST1 + (row * 16u + u.pn * 4u + wc) * 8u)) = st; }
        asm volatile("" ::: "memory");
      }
  }
};
__device__ __forceinline__ void phase7(const MP& p, LAS unsigned char* lds) {
  int K = 1024; asm volatile("" : "+s"(K));
  pg8::Gemm g{(const bf16_t*)(p.ws + WS_MIX), (const bf16_t*)(p.ws + WS_WOT), NLAT, 1024, K};
  pg8::StaticOrder S; S.init(NLAT, 1024, gridDim.x, blockIdx.x);
  EpiOut E{p.in[I_X], p.out, p.ws};
  pg8::gemm_phase<EpiOut, pg8::StaticOrder, true, true>(lds, g, S, E);
}

struct TokInfo { int bucket, pos; float wa, wb; };
__device__ __forceinline__ void phase8(const MP& p, LAS unsigned char* lds) {
  const int tid = threadIdx.x, wid = tid >> 6, lane = tid & 63; unsigned char* ws = p.ws;
  LAS float* wr = (LAS float*)lds;
  LAS int* tb = (LAS int*)(lds + 81920);
  LAS float* tw = (LAS float*)(lds + 81920 + 512);
  LAS int* base = (LAS int*)(lds + 81920 + 2048);
  for (int e = tid; e < 1024 * 20; e += NTH) { const int k = e / 20, j = e - k * 20; wr[e] = j < 4 ? p.in[I_WRG][k * 4 + j] : p.in[I_WRE][k * 16 + (j - 4)]; }
  __syncthreads();
  float* out = p.out; const float* mod = (const float*)(ws + WS_MOD); bf16_t* H = (bf16_t*)(ws + WS_H); int* cnt = (int*)(ws + WS_CNT);
  TokInfo* TI = (TokInfo*)(ws + WS_TOKINFO); const float* ST = (const float*)(ws + WS_ST1);
  for (int t0 = blockIdx.x * 128; t0 < NLAT; t0 += gridDim.x * 128) {
    const int b = t0 >> 12; const float* mb = mod + b * 6144;
    for (int i = 0; i < 16; ++i) {
      const int lt = wid * 16 + i, tok = t0 + lt;
      float s = 0.f, q = 0.f; if (lane < 16) { const f32x2 v = *(const f32x2*)(ST + ((size_t)tok * 16 + lane) * 2); s = v[0]; q = v[1]; }
#pragma unroll
      for (int o = 1; o < 16; o <<= 1) { s += __shfl_xor(s, o); q += __shfl_xor(q, o); }
      s = __shfl(s, 0); q = __shfl(q, 0);
      const float mean = s * (1.f / 1024.f), rstd = rsqrtf(fmaxf(q * (1.f / 1024.f) - mean * mean, 0.f) + EPS);
      float lg[20];
#pragma unroll
      for (int j = 0; j < 20; ++j) lg[j] = 0.f;
#pragma unroll
      for (int qd = 0; qd < 4; ++qd) { const int c = qd * 256 + lane * 4; float* zp = out + (size_t)tok * 1024 + c;
        const f32x4 z = *(const f32x4*)zp; const f32x4 g1 = *(const f32x4*)(p.in[I_LN1G] + c), b1 = *(const f32x4*)(p.in[I_LN1B] + c);
        const f32x4 x1 = (z - mean) * rstd * g1 + b1; *(f32x4*)zp = x1;
        const f32x4 sh = *(const f32x4*)(mb + 3072 + c), sc = *(const f32x4*)(mb + 4096 + c); const f32x4 hv = x1 * (1.f + sc) + sh;
        u32x2 hw; hw.x = cvt_pk(hv[0], hv[1]); hw.y = cvt_pk(hv[2], hv[3]); *(u32x2*)(H + (size_t)tok * 1024 + c) = hw;
#pragma unroll
        for (int e = 0; e < 4; ++e) { const LAS float* w = wr + (c + e) * 20;
#pragma unroll
          for (int j = 0; j < 20; ++j) lg[j] += hv[e] * w[j]; } }
#pragma unroll
      for (int j = 0; j < 20; ++j) { float v = lg[j];
#pragma unroll
        for (int o = 32; o > 0; o >>= 1) v += __shfl_xor(v, o);
        lg[j] = v; }
      if (lane == 0) {
        float gl[4]; float m = -3e38f;
#pragma unroll
        for (int j = 0; j < 4; ++j) { gl[j] = lg[j] + p.in[I_BRG][j]; m = fmaxf(m, gl[j]); }
        float ssum = 0.f;
#pragma unroll
        for (int j = 0; j < 4; ++j) { gl[j] = expf(gl[j] - m); ssum += gl[j]; }
        int gt = 0; float pg = gl[0];
#pragma unroll
        for (int j = 1; j < 4; ++j) if (gl[j] > pg) { pg = gl[j]; gt = j; }
        pg /= ssum;
        float el[4]; float em = -3e38f;
#pragma unroll
        for (int j = 0; j < 4; ++j) { const float v = gt == 0 ? lg[4 + j] : gt == 1 ? lg[8 + j] : gt == 2 ? lg[12 + j] : lg[16 + j]; el[j] = v + p.in[I_BRE][gt * 4 + j]; em = fmaxf(em, el[j]); }
        float es = 0.f;
#pragma unroll
        for (int j = 0; j < 4; ++j) { el[j] = expf(el[j] - em); es += el[j]; }
        int i1 = 0; float p1 = el[0];
#pragma unroll
        for (int j = 1; j < 4; ++j) if (el[j] > p1) { p1 = el[j]; i1 = j; }
        int i2 = -1; float p2 = -1.f;
#pragma unroll
        for (int j = 0; j < 4; ++j) if (j != i1 && el[j] > p2) { p2 = el[j]; i2 = j; }
        const float w1 = p1 / (p1 + p2) * pg, w2 = p2 / (p1 + p2) * pg;
        const int a = i1 < i2 ? i1 : i2, bb = i1 < i2 ? i2 : i1; const float wa = i1 < i2 ? w1 : w2, wb = i1 < i2 ? w2 : w1;
        const int pr = a == 0 ? bb - 1 : (a == 1 ? bb + 1 : 5);
        tb[lt] = gt * 6 + pr; tw[lt * 2] = wa; tw[lt * 2 + 1] = wb;
      }
    }
    __syncthreads();
    if (tid < 24) { int c = 0; for (int j = 0; j < 128; ++j) c += (tb[j] == tid); base[tid] = c ? atomicAdd(&cnt[tid], c) : 0; }
    __syncthreads();
    if (tid < 128) { const int bk = tb[tid]; int r = 0; for (int j = 0; j < tid; ++j) r += (tb[j] == bk);
      TokInfo ti; ti.bucket = bk; ti.pos = base[bk] + r; ti.wa = tw[tid * 2]; ti.wb = tw[tid * 2 + 1]; TI[t0 + tid] = ti; }
    __syncthreads();
  }
}

__device__ __forceinline__ void phase9(const MP& p, LAS unsigned char* lds) {
  const int tid = threadIdx.x, wid = tid >> 6, lane = tid & 63; unsigned char* ws = p.ws;
  LAS int* off = (LAS int*)lds;
  LAS int* cn = off + 32;
  int* cw = (int*)(ws + WS_CNT); int* ROWTOK = (int*)(ws + WS_ROWTOK); f32x2* ROWW = (f32x2*)(ws + WS_ROWTOK + 256 * 1024);
  if (tid == 0) { int o = 0; for (int k = 0; k < 24; ++k) { const int c = cw[k]; cn[k] = c; off[k] = o; o += ((c + 255) >> 8) << 8; } off[24] = o;
    if (blockIdx.x == 0) { cw[CW_NT] = o >> 8; int t = 0; for (int k = 0; k < 24; ++k) for (int j = 0; j < ((cn[k] + 255) >> 8); ++j) cw[CW_TB + t++] = k; } }
  __syncthreads();
  for (int k = 0; k < 24; ++k) { const int lo = off[k] + cn[k], hi = off[k + 1]; for (int r = lo + blockIdx.x * NTH + tid; r < hi; r += gridDim.x * NTH) ROWTOK[r] = -1; }
  const TokInfo* TI = (const TokInfo*)(ws + WS_TOKINFO); const bf16_t* H = (const bf16_t*)(ws + WS_H); bf16_t* HP = (bf16_t*)(ws + WS_HPERM);
  for (int tok = blockIdx.x * 8 + wid; tok < NLAT; tok += gridDim.x * 8) {
    const TokInfo ti = TI[tok]; const int row = off[ti.bucket] + ti.pos;
    if (lane == 0) { ROWTOK[row] = tok; f32x2 w = {ti.wa, ti.wb}; ROWW[row] = w; }
    const u32x4* src = (const u32x4*)(H + (size_t)tok * 1024); u32x4* dst = (u32x4*)(HP + (size_t)row * 1024);
    const u32x4 a = src[lane], b2 = src[64 + lane]; dst[lane] = a; dst[64 + lane] = b2;
  }
}

struct MoeOrder {
  int nwg, G, c; const int* tb;
  __device__ void init(const int* cw, int G_, int c_) { nwg = cw[CW_NT] * 4; G = G_; c = c_; tb = cw + CW_TB; }
  __device__ bool next(int i, pg8::Unit& u) const { const int L = i * G + c; if (L >= nwg) return false; u.pm = L >> 2; u.pn = tb[L >> 2] * 4 + (L & 3); return true; }
  __device__ __forceinline__ void a_ready(const pg8::Unit&) const {}
  __device__ __forceinline__ void done(const pg8::Unit&) const {}
};

struct EpiSwiglu {
  static constexpr bool PERM = true, AFTER_DRAIN = false;
  unsigned char* ws;
  __device__ __forceinline__ void operator()(const f32x4 (&acc)[2][2][4][2], const pg8::Unit& u, int wr, int wc, int fr, int fq) const {
    asm volatile("" : "+v"(fr), "+v"(fq));
    const unsigned row0 = u.pm * 256 + wr * 64 + fr; const unsigned pnl = u.pn & 3, slot = pnl >> 1, hb = pnl & 1;
    const unsigned colb = (slot * 256u + hb * 128u + wc * 32 + 8 * fq) * 2u;
#pragma unroll
    for (int ai = 0; ai < 2; ++ai)
#pragma unroll
      for (int m = 0; m < 4; ++m) {
        const unsigned row = row0 + ai * 128 + m * 16; const float w = *(const float*)(ws + (unsigned)(WS_ROWTOK + 256 * 1024 + (row * 2u + slot) * 4u));
        float he[8];
#pragma unroll
        for (int n = 0; n < 2; ++n)
#pragma unroll
          for (int e = 0; e < 4; ++e) { const float g = acc[ai][0][m][n][e], up = acc[ai][1][m][n][e]; he[n * 4 + e] = g / (1.f + __expf(-g)) * up * w; }
        u32x4 o; o.x = cvt_pk(he[0], he[1]); o.y = cvt_pk(he[2], he[3]); o.z = cvt_pk(he[4], he[5]); o.w = cvt_pk(he[6], he[7]);
        *(u32x4*)(ws + (unsigned)(WS_HE + row * 1024u + colb)) = o;
        asm volatile("" ::: "memory");
      }
  }
};
__device__ __forceinline__ void phase10(const MP& p, LAS unsigned char* lds) {
  int K = 1024; asm volatile("" : "+s"(K));
  pg8::Gemm g{(const bf16_t*)(p.ws + WS_HPERM), (const bf16_t*)(p.ws + WS_W1T), 0, 0, K};
  MoeOrder S; S.init((const int*)(p.ws + WS_CNT), gridDim.x, blockIdx.x);
  EpiSwiglu E{p.ws};
  pg8::gemm_phase<EpiSwiglu, MoeOrder, true, true>(lds, g, S, E);
}

struct EpiMoe {
  static constexpr bool PERM = false, AFTER_DRAIN = false;
  float* out; unsigned char* ws;
  __device__ __forceinline__ void operator()(const f32x4 (&acc)[2][2][4][2], const pg8::Unit& u, int wr, int wc, int fr, int fq) const {
    asm volatile("" : "+v"(fr), "+v"(fq));
    const unsigned row0 = u.pm * 256 + wr * 64 + fr; const unsigned pnl = u.pn & 3; const unsigned col0 = pnl * 256 + wc * 32 + 4 * fq;
#pragma unroll
    for (int ai = 0; ai < 2; ++ai)
#pragma unroll
      for (int m = 0; m < 4; ++m) {
        const unsigned row = row0 + ai * 128 + m * 16; const int tok = *(const int*)(ws + (unsigned)(WS_ROWTOK + row * 4u));
        const bool live = tok >= 0; const unsigned tk = live ? (unsigned)tok : 0u; const unsigned b = tk >> 12; const unsigned eo = tk * 1024u + col0; float s = 0.f, q = 0.f;
#pragma unroll
        for (int bj = 0; bj < 2; ++bj)
#pragma unroll
          for (int n = 0; n < 2; ++n) { const f32x4 gt = *(const f32x4*)(ws + (unsigned)(WS_MOD + (b * 6144u + 5120u + col0 + bj * 128 + n * 16) * 4u));
            const f32x4 xv = *(const f32x4*)(out + eo + bj * 128 + n * 16); const f32x4 z = xv * ALPHA + gt * acc[ai][bj][m][n];
            if (live) *(f32x4*)(out + eo + bj * 128 + n * 16) = z; s += (z[0] + z[1]) + (z[2] + z[3]); q += (z[0] * z[0] + z[1] * z[1]) + (z[2] * z[2] + z[3] * z[3]); }
        s += __shfl_xor(s, 16); s += __shfl_xor(s, 32); q += __shfl_xor(q, 16); q += __shfl_xor(q, 32);
        if (fq == 0 && live) { f32x2 st = {s, q}; *(f32x2*)(ws + (unsigned)(WS_ST2 + (tk * 16u + pnl * 4u + wc) * 8u)) = st; }
        asm volatile("" ::: "memory");
      }
  }
};
__device__ __forceinline__ void phase11(const MP& p, LAS unsigned char* lds) {
  int K = 512; asm volatile("" : "+s"(K));
  pg8::Gemm g{(const bf16_t*)(p.ws + WS_HE), (const bf16_t*)(p.ws + WS_W2T), 0, 0, K};
  MoeOrder S; S.init((const int*)(p.ws + WS_CNT), gridDim.x, blockIdx.x);
  EpiMoe E{p.out, p.ws};
  pg8::gemm_phase<EpiMoe, MoeOrder, true, true>(lds, g, S, E);
}

__device__ __forceinline__ void phase12(const MP& p) {
  const int tid = threadIdx.x, wid = tid >> 6, lane = tid & 63; float* out = p.out; const float* ST = (const float*)(p.ws + WS_ST2);
  for (int tok = blockIdx.x * 8 + wid; tok < NLAT; tok += gridDim.x * 8) {
    float s = 0.f, q = 0.f; if (lane < 16) { const f32x2 v = *(const f32x2*)(ST + ((size_t)tok * 16 + lane) * 2); s = v[0]; q = v[1]; }
#pragma unroll
    for (int o = 1; o < 16; o <<= 1) { s += __shfl_xor(s, o); q += __shfl_xor(q, o); }
    s = __shfl(s, 0); q = __shfl(q, 0);
    const float mean = s * (1.f / 1024.f), rstd = rsqrtf(fmaxf(q * (1.f / 1024.f) - mean * mean, 0.f) + EPS);
#pragma unroll
    for (int qd = 0; qd < 4; ++qd) { const int c = qd * 256 + lane * 4; float* zp = out + (size_t)tok * 1024 + c;
      const f32x4 z = *(const f32x4*)zp; const f32x4 g2 = *(const f32x4*)(p.in[I_LN2G] + c), b2 = *(const f32x4*)(p.in[I_LN2B] + c);
      *(f32x4*)zp = (z - mean) * rstd * g2 + b2; }
  }
}
}
namespace mk {
namespace cg = cooperative_groups;
__device__ __forceinline__ void grid_barrier(unsigned* ctr, unsigned target) {
  asm volatile("s_waitcnt vmcnt(0)" ::: "memory");
  __syncthreads();
  if (threadIdx.x == 0) {
    __builtin_amdgcn_fence(__ATOMIC_RELEASE, "agent");
    asm volatile("s_waitcnt vmcnt(0)" ::: "memory");
    __hip_atomic_fetch_add(ctr, 1u, __ATOMIC_RELAXED, __HIP_MEMORY_SCOPE_AGENT);
    unsigned spins = 0;
    while (__hip_atomic_load(ctr, __ATOMIC_RELAXED, __HIP_MEMORY_SCOPE_AGENT) < target) { __builtin_amdgcn_s_sleep(8); if (++spins > (1u << 24)) break; }
    __builtin_amdgcn_fence(__ATOMIC_ACQUIRE, "agent");
    asm volatile("s_waitcnt vmcnt(0)" ::: "memory");
  }
  __syncthreads();
}
__global__ void __launch_bounds__(NTH, 2) mega(MP p) {
  extern __shared__ __attribute__((aligned(16))) unsigned char lds_raw[];
  LAS unsigned char* lds = (LAS unsigned char*)lds_raw;
  cg::grid_group grid = cg::this_grid();
  const int lo = p.ph_lo, hi = p.ph_hi;
#define IN(k) (lo <= (k) && (k) < hi)
#define SEAM(k) do { if (IN(k) && IN((k) + 1)) { if ((k) == 0) { __threadfence(); grid.sync(); __threadfence(); } else grid_barrier(bar, (unsigned)(k) * gridDim.x); } } while (0)
  unsigned* bar = (unsigned*)(p.ws + WS_BAR);
  if (IN(0)) phase0(p, lds);
  SEAM(0);
  if (IN(1)) phase1(p);
  SEAM(1);
  if (IN(2)) phase2(p, lds);
  SEAM(2);
  if (IN(3)) phase3(p, lds);
  SEAM(3);
  if (IN(4)) { phase4_gemm(p, lds); gla::stage1(p, lds); }
  SEAM(4);
  if (IN(5)) { gla::stage2(p); phase5_attn(p, lds); }
  SEAM(5);
  if (IN(6)) { gla::stage3(p, lds); prep_expert_weights(p, lds); }
  SEAM(6);
  if (IN(7)) phase7(p, lds);
  SEAM(7);
  if (IN(8)) phase8(p, lds);
  SEAM(8);
  if (IN(9)) phase9(p, lds);
  SEAM(9);
  if (IN(10)) phase10(p, lds);
  SEAM(10);
  if (IN(11)) phase11(p, lds);
  SEAM(11);
  if (IN(12)) phase12(p);
#undef IN
#undef SEAM
}
}
extern "C" void kernel_launch(void* const* d_in, const int* in_sizes, int n_in,
                              void* d_out, int out_size, void* d_ws, size_t ws_size, hipStream_t stream) {
  static int grid = 0;
  if (!grid) {
    if (hipFuncSetAttribute((const void*)mk::mega, hipFuncAttributeMaxDynamicSharedMemorySize, mk::LDS_BYTES) != hipSuccess) { fprintf(stderr, "set attr failed\n"); return; }
    int dev = 0, cus = 0, per_cu = 0;
    hipGetDevice(&dev); hipDeviceGetAttribute(&cus, hipDeviceAttributeMultiprocessorCount, dev);
    hipOccupancyMaxActiveBlocksPerMultiprocessor(&per_cu, (const void*)mk::mega, mk::NTH, mk::LDS_BYTES);
    if (per_cu < 1 || cus < 1) { fprintf(stderr, "occupancy query: %d blocks/CU, %d CUs\n", per_cu, cus); return; }
    grid = cus;
  }
  if (ws_size < mk::WS_NEED || n_in != 28 || out_size != mk::NLAT * mk::D) { fprintf(stderr, "unexpected sizes\n"); return; }
  mk::MP a{}; for (int i = 0; i < 28; ++i) a.in[i] = (const float*)d_in[i]; a.out = (float*)d_out; a.ws = (unsigned char*)d_ws;
  a.ph_lo = 0; a.ph_hi = 13; a.coop = 1; a.pad = 0;
  (void)hipMemsetAsync((char*)d_ws + mk::WS_BAR, 0, 256, stream);
  void* args[] = {&a};
  hipError_t e = hipLaunchCooperativeKernel((const void*)mk::mega, dim3(grid), dim3(mk::NTH), args, mk::LDS_BYTES, stream);
  if (e != hipSuccess) fprintf(stderr, "cooperative launch failed: %s (grid %d)\n", hipGetErrorString(e), grid);
}
```

```cpp
#include <hip/hip_runtime.h>
#include <hip/hip_cooperative_groups.h>
#include <cstdio>
#include <cstdint>
#include <math.h>
namespace pg8 {
#define PG8_LAS __attribute__((address_space(3)))
typedef unsigned short bf16_t;
typedef short bf16x8 __attribute__((ext_vector_type(8)));
typedef float f32x4 __attribute__((ext_vector_type(4)));
typedef unsigned u32x4 __attribute__((ext_vector_type(4)));
constexpr int BM = 256, BK = 64, HALF = 128, HTB = HALF * BK * 2  , STAGE_BYTES = 8 * HTB, NXCD = 8, WGM = 8;

__host__ __device__ __forceinline__ int lds_byte(int r, int c) { const int st = (r >> 4) * 2 + (c >> 5), rr = r & 15, cc = c & 31, ob = rr * 64 + cc * 2; return st * 1024 + (ob ^ (((ob >> 9) & 1) << 5)); }
__host__ __device__ __forceinline__ void stage_rc(int b, int& R, int& C) { const int st = b / 1024, sb = b % 1024, swz = sb ^ (((sb >> 9) & 1) << 5); R = (st >> 1) * 16 + swz / 64; C = (st & 1) * 32 + (swz % 64) / 2; }
__host__ __device__ __forceinline__ int perm32(int rho) { const int n = rho >> 4, i = rho & 15; return 8 * (i >> 2) + 4 * n + (i & 3); }

struct Unit { int pm, pn, aux; };
struct Gemm { const bf16_t* A; const bf16_t* Bt; int M, N, K; };

struct StaticOrder {
    int nM, nN, nwg, G, c;
    __host__ __device__ void init(int M, int N, int G_, int c_) { nM = M / BM; nN = N / BM; nwg = nM * nN; G = G_; c = c_; }
    __host__ __device__ bool next(int i, Unit& u) const {
        const long L = (long)i * G + c; if (L >= nwg) return false;
        int wgid = (int)L; { const int q = nwg / NXCD, r = nwg % NXCD, xcd = wgid % NXCD, off = wgid / NXCD; wgid = (xcd < r ? xcd * (q + 1) : r * (q + 1) + (xcd - r) * q) + off; }
        const int nig = WGM * nN, gid = wgid / nig, fm = gid * WGM, gsz = (nM - fm) < WGM ? (nM - fm) : WGM;
        u.pm = fm + ((wgid % nig) % gsz); u.pn = (wgid % nig) / gsz; return true;
    }
    __device__ __forceinline__ void a_ready(const Unit&) const {}
    __device__ __forceinline__ void done(const Unit&) const {}
};

template <class Epi, class Sched, bool ALIGN_EPI = false, bool SP2 = false>
__device__ __forceinline__ void gemm_phase(PG8_LAS unsigned char* lds, const Gemm g, const Sched& S, const Epi& E) {
    const int tid = threadIdx.x, wid = __builtin_amdgcn_readfirstlane(tid >> 6), lane = tid & 63, wr = wid >> 2, wc = wid & 3, fr = lane & 15, fq = lane >> 4;
    const int K = g.K, nt = K / BK;
    unsigned voffA[2], voffB[2];
#pragma unroll
    for (int i = 0; i < 2; ++i) { int R, C; stage_rc(tid * 16 + i * 8192, R, C); const int Rb = Epi::PERM ? ((R & ~31) + perm32(R & 31)) : R;
        voffA[i] = (unsigned)(R * K + C) * 2u; voffB[i] = (unsigned)(Rb * K + C) * 2u; }
    const size_t kstep = (size_t)(BK * 2);
    const size_t hstep = (size_t)HALF * K * 2;
    const size_t tstep = 2 * hstep;
    const unsigned ldsw = (unsigned)wid * 1024u;
    const int aoff = lds_byte(wr * 64 + fr, fq * 8), boff = lds_byte(wc * 32 + fr, fq * 8);
#define PG8_SA(b, h) (((b) * 2 + (h)) * HTB)
#define PG8_SB(b, h) ((4 + (b) * 2 + (h)) * HTB)
#define PG8_STAGE(bufoff, gbase, voff) do { _Pragma("unroll") for (int _i = 0; _i < 2; ++_i) \
        __builtin_amdgcn_global_load_lds((const unsigned*)((const char*)(gbase) + (voff)[_i]), (PG8_LAS unsigned*)(lds + (bufoff) + ldsw + _i * 8192), 16, 0, 0); } while (0)
#define PG8_LDA(dst, b, h) do { _Pragma("unroll") for (int m = 0; m < 4; ++m) _Pragma("unroll") for (int k = 0; k < 2; ++k) dst[m][k] = *(const PG8_LAS bf16x8*)(lds + PG8_SA(b, h) + aoff + m * 2048 + k * 1024); } while (0)
#define PG8_LDB(dst, b, h) do { _Pragma("unroll") for (int n = 0; n < 2; ++n) _Pragma("unroll") for (int k = 0; k < 2; ++k) dst[n][k] = *(const PG8_LAS bf16x8*)(lds + PG8_SB(b, h) + boff + n * 2048 + k * 1024); } while (0)
#define PG8_MMA(ai, bj, At, Bt) do { __builtin_amdgcn_s_setprio(1); _Pragma("unroll") for (int m = 0; m < 4; ++m) _Pragma("unroll") for (int n = 0; n < 2; ++n) _Pragma("unroll") for (int k = 0; k < 2; ++k) \
        acc[ai][bj][m][n] = __builtin_amdgcn_mfma_f32_16x16x32_bf16(Bt[n][k], At[m][k], acc[ai][bj][m][n], 0, 0, 0); __builtin_amdgcn_s_setprio(0); } while (0)
#define PG8_WAIT_V(n) asm volatile("s_waitcnt vmcnt(" #n ")" ::: "memory")
#define PG8_WAIT_L(n) asm volatile("s_waitcnt lgkmcnt(" #n ")" ::: "memory")
#define PG8_BAR __builtin_amdgcn_s_barrier()
#define PG8_SCHED __builtin_amdgcn_sched_barrier(0)
    Unit cur, nxt; int ui = 0;
    if (!S.next(0, cur)) return;
    f32x4 acc[2][2][4][2];
#pragma unroll
    for (int a = 0; a < 2; ++a)
#pragma unroll
        for (int b = 0; b < 2; ++b)
#pragma unroll
            for (int m = 0; m < 4; ++m)
#pragma unroll
                for (int n = 0; n < 2; ++n) acc[a][b][m][n] = (f32x4){0.f, 0.f, 0.f, 0.f};
    bf16x8 At[4][2], B0[2][2], B1[2][2];
    const char* cA = (const char*)g.A + (size_t)cur.pm * tstep; const char* cB = (const char*)g.Bt + (size_t)cur.pn * tstep;
    S.a_ready(cur);
    if constexpr (SP2) {
        PG8_STAGE(PG8_SB(0, 0), cB, voffB); PG8_STAGE(PG8_SB(0, 1), cB + hstep, voffB); PG8_STAGE(PG8_SA(0, 0), cA, voffA); PG8_STAGE(PG8_SA(0, 1), cA + hstep, voffA);
        if (wr == 1) PG8_BAR;
        PG8_WAIT_V(2); PG8_BAR;
        PG8_STAGE(PG8_SB(1, 0), cB + kstep, voffB); PG8_STAGE(PG8_SA(1, 0), cA + kstep, voffA); PG8_STAGE(PG8_SB(1, 1), cB + hstep + kstep, voffB);
        PG8_WAIT_V(6); PG8_BAR;
    } else {
        PG8_STAGE(PG8_SB(0, 0), cB, voffB); PG8_STAGE(PG8_SA(0, 0), cA, voffA); PG8_STAGE(PG8_SB(0, 1), cB + hstep, voffB); PG8_STAGE(PG8_SA(0, 1), cA + hstep, voffA);
        if (wr == 1) PG8_BAR;
        PG8_WAIT_V(4); PG8_BAR;
        PG8_STAGE(PG8_SB(1, 0), cB + kstep, voffB); PG8_STAGE(PG8_SA(1, 0), cA + kstep, voffA); PG8_STAGE(PG8_SB(1, 1), cB + hstep + kstep, voffB);
        PG8_WAIT_V(6); PG8_BAR;
    }
    for (;;) {
        const bool has_next = S.next(ui + 1, nxt);
        const char* nA = has_next ? (const char*)g.A + (size_t)nxt.pm * tstep : cA; const char* nB = has_next ? (const char*)g.Bt + (size_t)nxt.pn * tstep : cB;
        for (int t = 0; t < nt; t += 2) {
            const bool last = (t == nt - 2);
            const char* a1 = cA + (size_t)(t + 1) * kstep;
            const char* a2 = last ? nA : cA + (size_t)(t + 2) * kstep; const char* b2 = last ? nB : cB + (size_t)(t + 2) * kstep;
            const char* a3 = a2 + kstep; const char* b3 = b2 + kstep;
            if (last && has_next) S.a_ready(nxt);
            if constexpr (SP2) {
            PG8_LDB(B0, 0, 0); PG8_LDB(B1, 0, 1); PG8_SCHED; PG8_LDA(At, 0, 0); PG8_STAGE(PG8_SA(1, 1), a1 + hstep, voffA);
            PG8_WAIT_V(8); PG8_WAIT_L(0); PG8_BAR; PG8_MMA(0, 0, At, B0); PG8_MMA(0, 1, At, B1); PG8_BAR; PG8_SCHED;
            PG8_LDA(At, 0, 1); PG8_STAGE(PG8_SB(0, 0), b2, voffB); PG8_STAGE(PG8_SB(0, 1), b2 + hstep, voffB); PG8_STAGE(PG8_SA(0, 0), a2, voffA);
            PG8_WAIT_V(8); PG8_WAIT_L(0); PG8_BAR; PG8_MMA(1, 0, At, B0); PG8_MMA(1, 1, At, B1); PG8_BAR; PG8_SCHED;
            PG8_LDB(B0, 1, 0); PG8_LDB(B1, 1, 1); PG8_SCHED; PG8_LDA(At, 1, 0); PG8_STAGE(PG8_SA(0, 1), a2 + hstep, voffA);
            PG8_WAIT_V(8); PG8_WAIT_L(0); PG8_BAR; PG8_MMA(0, 0, At, B0); PG8_MMA(0, 1, At, B1); PG8_BAR; PG8_SCHED;
            PG8_LDA(At, 1, 1); PG8_STAGE(PG8_SB(1, 0), b3, voffB); PG8_STAGE(PG8_SB(1, 1), b3 + hstep, voffB); PG8_STAGE(PG8_SA(1, 0), a3, voffA);
            PG8_WAIT_V(8); PG8_WAIT_L(0); PG8_BAR; PG8_MMA(1, 0, At, B0); PG8_MMA(1, 1, At, B1); PG8_BAR; PG8_SCHED;
            } else {
            PG8_LDB(B0, 0, 0); PG8_SCHED; PG8_LDA(At, 0, 0); PG8_STAGE(PG8_SA(1, 1), a1 + hstep, voffA);
            PG8_WAIT_L(8); PG8_BAR; PG8_WAIT_L(0); PG8_MMA(0, 0, At, B0); PG8_BAR; PG8_SCHED;
            PG8_LDB(B1, 0, 1); PG8_STAGE(PG8_SB(0, 0), b2, voffB);
            PG8_BAR; PG8_WAIT_L(0); PG8_MMA(0, 1, At, B1); PG8_BAR;
            PG8_LDA(At, 0, 1); PG8_STAGE(PG8_SA(0, 0), a2, voffA);
            PG8_BAR; PG8_WAIT_L(0); PG8_MMA(1, 0, At, B0); PG8_BAR; PG8_SCHED;
            PG8_STAGE(PG8_SB(0, 1), b2 + hstep, voffB);
            PG8_WAIT_V(6); PG8_BAR; PG8_MMA(1, 1, At, B1); PG8_BAR;
            PG8_LDB(B0, 1, 0); PG8_SCHED; PG8_LDA(At, 1, 0); PG8_STAGE(PG8_SA(0, 1), a2 + hstep, voffA);
            PG8_WAIT_L(8); PG8_BAR; PG8_WAIT_L(0); PG8_MMA(0, 0, At, B0); PG8_BAR; PG8_SCHED;
            PG8_LDB(B1, 1, 1); PG8_STAGE(PG8_SB(1, 0), b3, voffB);
            PG8_BAR; PG8_WAIT_L(0); PG8_MMA(0, 1, At, B1); PG8_BAR;
            PG8_LDA(At, 1, 1); PG8_STAGE(PG8_SA(1, 0), a3, voffA);
            PG8_BAR; PG8_WAIT_L(0); PG8_MMA(1, 0, At, B0); PG8_BAR; PG8_SCHED;
            PG8_STAGE(PG8_SB(1, 1), b3 + hstep, voffB);
            PG8_WAIT_V(6); PG8_BAR; PG8_MMA(1, 1, At, B1); PG8_BAR;
            }
        }
        if constexpr (ALIGN_EPI) { if (wr == 0) PG8_BAR; }
        if constexpr (!Epi::AFTER_DRAIN) { E(acc, cur, wr, wc, fr, fq); S.done(cur); }
        if (!has_next) break;
#pragma unroll
        for (int a = 0; a < 2; ++a)
#pragma unroll
            for (int b = 0; b < 2; ++b)
#pragma unroll
                for (int m = 0; m < 4; ++m)
#pragma unroll
                    for (int n = 0; n < 2; ++n) acc[a][b][m][n] = (f32x4){0.f, 0.f, 0.f, 0.f};
        cur = nxt; cA = nA; cB = nB; ++ui;
        if constexpr (ALIGN_EPI) { if (wr == 1) PG8_BAR; }
    }
    PG8_WAIT_V(0);
    if constexpr (!ALIGN_EPI) { if (wr == 0) PG8_BAR; }
    PG8_BAR;
    if constexpr (Epi::AFTER_DRAIN) { E.fused(acc, cur, wr, wc, fr, fq, lds, wid, lane); S.done(cur); }
#undef PG8_SA
#undef PG8_SB
#undef PG8_STAGE
#undef PG8_LDA
#undef PG8_LDB
#undef PG8_MMA
#undef PG8_WAIT_V
#undef PG8_WAIT_L
#undef PG8_BAR
#undef PG8_SCHED
}
}
namespace mk {
using pg8::bf16_t; using pg8::bf16x8; using pg8::f32x4; using pg8::u32x4;
typedef float f32x8 __attribute__((ext_vector_type(8)));
typedef float f32x16 __attribute__((ext_vector_type(16)));
typedef float f32x2 __attribute__((ext_vector_type(2)));
typedef unsigned u32x2 __attribute__((ext_vector_type(2)));
#define LAS __attribute__((address_space(3)))

constexpr int NTH = 512;
constexpr int D = 1024, NB = 8, SEQ = 4096, CTXL = 256;
constexpr int NLAT = NB * SEQ;
constexpr int NCTX = NB * CTXL;
constexpr int MROWS = NLAT + NCTX;
constexpr float ALPHA = 1.189207115002721f;
constexpr float EPS = 1e-6f;
constexpr float QSCALE = 0.10206207261596575f * 1.4426950408889634f;

constexpr size_t MiB = 1u << 20;
constexpr size_t WS_MOD = 0;
constexpr size_t WS_ROPE = 1 * MiB;
constexpr size_t WS_RS = 2 * MiB;
constexpr size_t WS_CNT = 3 * MiB;
constexpr size_t WS_TOKINFO = 4 * MiB;
constexpr size_t WS_ROWTOK = 5 * MiB;
constexpr size_t WS_BAR = 3 * MiB + 65536;
constexpr size_t WS_ST1 = 6 * MiB;
constexpr size_t WS_ST2 = 10 * MiB;
constexpr size_t WS_WINT = 16 * MiB, WS_WOT = 20 * MiB, WS_WUPT = 22 * MiB;
constexpr size_t WS_U = 24 * MiB;
constexpr size_t WS_MIX = WS_U;
constexpr size_t WS_QG = 92 * MiB, WS_KG = 109 * MiB, WS_VG = 126 * MiB, WS_RG = 160 * MiB;
constexpr size_t WS_A2 = 194 * MiB;
constexpr size_t WS_KR = WS_A2 + 26738688;
constexpr size_t WS_GFB = WS_KR + 4456448;
constexpr size_t WS_LGF = 228 * MiB, WS_LGB = 262 * MiB;
constexpr size_t WS_QC = 296 * MiB, WS_KC = 344 * MiB, WS_VC = 395 * MiB;
constexpr size_t WS_DS = 429 * MiB;
constexpr size_t WS_END = 497 * MiB;
constexpr size_t WS_W1T = 296 * MiB, WS_W2T = 344 * MiB;
constexpr size_t WS_H = 92 * MiB;
constexpr size_t WS_HPERM = 156 * MiB;
constexpr size_t WS_HE = 232 * MiB;
constexpr size_t WS_NEED = 497 * MiB;

constexpr int LDS_BYTES = 140 * 1024;

struct MP { const float* in[28]; float* out; unsigned char* ws; int ph_lo, ph_hi, coop, pad; };
enum { I_X = 0, I_C, I_CTX, I_CCTX, I_WADA, I_BADA, I_WIN, I_WGKF, I_BGKF, I_WGKB, I_BGKB, I_GLAG, I_QNG, I_WUQ, I_KVNG, I_WUKV, I_WO, I_LN1G, I_LN1B,
       I_WRG, I_BRG, I_WRE, I_BRE, I_WEG, I_WEU, I_WED, I_LN2G, I_LN2B };

typedef __bf16 bf16x2_t __attribute__((ext_vector_type(2)));
__device__ __forceinline__ unsigned cvt_pk(float lo, float hi) { f32x2 v = {lo, hi}; bf16x2_t b = __builtin_convertvector(v, bf16x2_t); return __builtin_bit_cast(unsigned, b); }
__device__ __forceinline__ float bf2f(unsigned short h) { return __uint_as_float(((unsigned)h) << 16); }
__device__ __forceinline__ float bflo(unsigned w) { return __uint_as_float(w << 16); }
__device__ __forceinline__ float bfhi(unsigned w) { return __uint_as_float(w & 0xffff0000u); }
__device__ __forceinline__ float silu_f(float x) { return x / (1.f + __expf(-x)); }

__device__ __forceinline__ int grow(int b, int r) { return r < SEQ ? b * SEQ + r : NLAT + b * CTXL + (r - SEQ); }

__host__ __device__ __forceinline__ int rope_unperm(int jp) { const int half = jp >> 4, i = (jp >> 1) & 7, sec = jp & 1; return half * 16 + sec * 8 + i; }

struct SrcWin {
  const float* w;
  __device__ __forceinline__ float operator()(int n, int k) const {
    int src;
    if (n < 1024) src = n;
    else if (n < 1536) src = 1056 + (n - 1024);
    else if (n < 1792) src = 1568 + (n - 1536);
    else { const int c = n - 1792;
      if (c < 128) src = 1824 + c;
      else if (c < 160) src = 1952 + rope_unperm(c - 128);
      else if (c < 176) src = 1024 + (c - 160);
      else if (c < 192) src = 1040 + (c - 176);
      else return 0.f; }
    return w[(size_t)k * 1984 + src];
  }
};
struct SrcWup {
  const float *wq, *gq, *wkv, *gkv;
  __device__ __forceinline__ float operator()(int n, int k) const {
    if (n < 768) { if (k >= 256) return 0.f; const int h = n / 96, dp = n % 96; const int d = dp < 64 ? dp : 64 + rope_unperm(dp - 64);
      return wq[(size_t)k * 768 + h * 96 + d] * gq[k]; }
    if (k < 256) return 0.f;
    return wkv[(size_t)(k - 256) * 1024 + (n - 768)] * gkv[k - 256];
  }
};
struct SrcWo { const float* w; __device__ __forceinline__ float operator()(int n, int k) const { return w[(size_t)k * 1024 + n]; } };
__host__ __device__ __forceinline__ void pair_ab(int p, int& a, int& b) { a = p < 3 ? 0 : (p < 5 ? 1 : 2); b = p < 3 ? p + 1 : (p < 5 ? p - 1 : 3); }
struct SrcW1 {
  const float *wg, *wu;
  __device__ __forceinline__ float operator()(int n, int k) const {
    const int e = n >> 9, r = n & 511, hb = r >> 8, rr = r & 255, hid = hb * 128 + (rr & 127);
    const long delta = (rr < 128) ? 0L : (long)(wu - wg);
    return wg[(long)(((size_t)e * 1024 + k) * 256 + hid) + delta];
  }
};
struct SrcW2 {
  const float* wd;
  __device__ __forceinline__ float operator()(int n, int k) const {
    const int bk = n >> 10, col = n & 1023, g = bk / 6, p = bk % 6; int a, b; pair_ab(p, a, b);
    const int e = g * 4 + ((k >> 8) ? b : a);
    return wd[((size_t)e * 256 + (k & 255)) * 1024 + col];
  }
};
template <class Src> __device__ __forceinline__ void wprep_tile(const Src& S, bf16_t* Wt, int K, int n0, int k0, LAS float* t) {
  const int tid = threadIdx.x;
  { const int nl = tid & 63, kk0 = tid >> 6;
#pragma unroll
    for (int i = 0; i < 16; ++i) { const int kk = kk0 + 8 * i; t[kk * 65 + nl] = S(n0 + nl, k0 + kk); } }
  __syncthreads();
  { const int nl = tid >> 3, ks = (tid & 7) * 16; u32x4 w, w2;
    w.x = cvt_pk(t[(ks + 0) * 65 + nl], t[(ks + 1) * 65 + nl]); w.y = cvt_pk(t[(ks + 2) * 65 + nl], t[(ks + 3) * 65 + nl]);
    w.z = cvt_pk(t[(ks + 4) * 65 + nl], t[(ks + 5) * 65 + nl]); w.w = cvt_pk(t[(ks + 6) * 65 + nl], t[(ks + 7) * 65 + nl]);
    w2.x = cvt_pk(t[(ks + 8) * 65 + nl], t[(ks + 9) * 65 + nl]); w2.y = cvt_pk(t[(ks + 10) * 65 + nl], t[(ks + 11) * 65 + nl]);
    w2.z = cvt_pk(t[(ks + 12) * 65 + nl], t[(ks + 13) * 65 + nl]); w2.w = cvt_pk(t[(ks + 14) * 65 + nl], t[(ks + 15) * 65 + nl]);
    bf16_t* d = Wt + (size_t)(n0 + nl) * K + k0 + ks; *(u32x4*)d = w; *(u32x4*)(d + 8) = w2; }
  __syncthreads();
}
template <class Src> __device__ __forceinline__ void wprep(const Src& S, bf16_t* Wt, int N, int K, LAS float* t, int& cursor) {
  const int tk = K / 128, tiles = (N / 64) * tk, G = gridDim.x;
  int first = ((int)blockIdx.x - cursor) % G; if (first < 0) first += G;
  for (int i = first; i < tiles; i += G) wprep_tile(S, Wt, K, (i / tk) * 64, (i % tk) * 128, t);
  cursor += tiles;
}

__device__ __forceinline__ void phase0(const MP& p, LAS unsigned char* lds) {
  const int tid = threadIdx.x, bid = blockIdx.x, G = gridDim.x;
  unsigned char* ws = p.ws;
  if (bid == 0) { int* cnt = (int*)(ws + WS_CNT); for (int i = tid; i < 4096; i += NTH) cnt[i] = 0; }
  { float* rope = (float*)(ws + WS_ROPE);
    for (int e = bid * NTH + tid; e < 4096 * 16; e += G * NTH) { const int s = e >> 4, a = e & 15, half = a >> 3, i = a & 7;
      const float pos = half ? (float)(s & 63) : (float)(s >> 6); const float inv = powf(10000.f, -(float)i / 8.f); const float ang = pos * inv;
      rope[e * 2] = cosf(ang); rope[e * 2 + 1] = sinf(ang); } }
  { LAS float* sc = (LAS float*)lds;
    LAS float* red = sc + 9 * 1024;
    const bool have = bid < 192;
    if (have) {
      for (int e = tid; e < 9 * 1024; e += NTH) { const int r = e >> 10, k = e & 1023; const float x = r < 8 ? p.in[I_C][r * 1024 + k] : p.in[I_CCTX][k]; sc[e] = x / (1.f + expf(-x)); }
      __syncthreads();
      for (int it = bid; it < 192; it += G) {
        const int col = it * 32 + (tid & 31), kg = tid >> 5; float acc[9];
#pragma unroll
        for (int r = 0; r < 9; ++r) acc[r] = 0.f;
        const float* w = p.in[I_WADA] + (size_t)(kg * 64) * 6144 + col;
#pragma unroll 8
        for (int k = 0; k < 64; ++k) { const float wv = w[(size_t)k * 6144];
#pragma unroll
          for (int r = 0; r < 9; ++r) acc[r] += sc[r * 1024 + kg * 64 + k] * wv; }
#pragma unroll
        for (int r = 0; r < 9; ++r) red[(kg * 9 + r) * 32 + (tid & 31)] = acc[r];
        __syncthreads();
        for (int e = tid; e < 9 * 32; e += NTH) { const int r = e >> 5, c = e & 31; float s = 0.f;
#pragma unroll
          for (int g = 0; g < 16; ++g) s += red[(g * 9 + r) * 32 + c];
          ((float*)(ws + WS_MOD))[r * 6144 + it * 32 + c] = s + p.in[I_BADA][it * 32 + c]; }
        __syncthreads();
      }
    }
    __syncthreads();
  }
  { LAS float* t = (LAS float*)lds; int cursor = 192;
    wprep(SrcWin{p.in[I_WIN]}, (bf16_t*)(ws + WS_WINT), 2048, 1024, t, cursor);
    wprep(SrcWup{p.in[I_WUQ], p.in[I_QNG], p.in[I_WUKV], p.in[I_KVNG]}, (bf16_t*)(ws + WS_WUPT), 1792, 384, t, cursor);
    wprep(SrcWo{p.in[I_WO]}, (bf16_t*)(ws + WS_WOT), 1024, 1024, t, cursor); }
}

__device__ __forceinline__ void phase1(const MP& p) {
  const float* mod = (const float*)(p.ws + WS_MOD); bf16_t* U = (bf16_t*)(p.ws + WS_U);
  const int total = MROWS * 128;
  for (int e = blockIdx.x * NTH + threadIdx.x; e < total; e += gridDim.x * NTH) {
    const int row = e >> 7, c8 = (e & 127) * 8;
    const float* src; const float* m;
    if (row < NLAT) { src = p.in[I_X] + (size_t)row * D; m = mod + (row >> 12) * 6144; } else { src = p.in[I_CTX] + (size_t)(row - NLAT) * D; m = mod + 8 * 6144; }
    const f32x4 x0 = *(const f32x4*)(src + c8), x1 = *(const f32x4*)(src + c8 + 4);
    const f32x4 s0 = *(const f32x4*)(m + c8), s1 = *(const f32x4*)(m + c8 + 4), g0 = *(const f32x4*)(m + 1024 + c8), g1 = *(const f32x4*)(m + 1024 + c8 + 4);
    const f32x4 u0 = x0 * (1.f + g0) + s0, u1 = x1 * (1.f + g1) + s1;
    u32x4 w; w.x = cvt_pk(u0[0], u0[1]); w.y = cvt_pk(u0[2], u0[3]); w.z = cvt_pk(u1[0], u1[1]); w.w = cvt_pk(u1[2], u1[3]);
    *(u32x4*)(U + (size_t)row * D + c8) = w;
  }
}

struct EpiIn {
  static constexpr bool PERM = true, AFTER_DRAIN = false;
  unsigned char* ws;
  __device__ __forceinline__ void operator()(const f32x4 (&acc)[2][2][4][2], const pg8::Unit& u, int wr, int wc, int fr, int fq) const {
    asm volatile("" : "+v"(fr), "+v"(fq));
    const int row0 = u.pm * 256 + wr * 64 + fr; const int pn = u.pn;
#pragma unroll
    for (int bj = 0; bj < 2; ++bj) {
      const int cl = bj * 128 + wc * 32 + 8 * fq;
      bf16_t* base = nullptr; int ld = 0; float* fbase = nullptr; bool skip = false;
      if (pn == 0) { base = (bf16_t*)(ws + WS_QG) + cl; ld = 256; }
      else if (pn == 1) { base = (bf16_t*)(ws + WS_KG) + cl; ld = 256; }
      else if (pn < 4) { base = (bf16_t*)(ws + WS_VG) + (pn - 2) * 256 + cl; ld = 512; }
      else if (pn < 6) { base = (bf16_t*)(ws + WS_RG) + (pn - 4) * 256 + cl; ld = 512; }
      else if (pn == 6) { base = (bf16_t*)(ws + WS_A2) + cl; ld = 384; }
      else { if (cl < 128) { base = (bf16_t*)(ws + WS_A2) + 256 + cl; ld = 384; }
             else if (cl < 160) fbase = (float*)(ws + WS_KR) + (cl - 128);
             else if (cl < 192) fbase = (float*)(ws + WS_GFB) + (cl - 160);
             else skip = true; }
      if (skip) continue;
#pragma unroll
      for (int ai = 0; ai < 2; ++ai)
#pragma unroll
        for (int m = 0; m < 4; ++m) { const int row = row0 + ai * 128 + m * 16; const f32x4 v0 = acc[ai][bj][m][0], v1 = acc[ai][bj][m][1];
          if (base) { u32x4 w; w.x = cvt_pk(v0[0], v0[1]); w.y = cvt_pk(v0[2], v0[3]); w.z = cvt_pk(v1[0], v1[1]); w.w = cvt_pk(v1[2], v1[3]);
            *(u32x4*)(base + (size_t)row * ld) = w; }
          else { *(f32x4*)(fbase + (size_t)row * 32) = v0; *(f32x4*)(fbase + (size_t)row * 32 + 4) = v1; } }
    }
  }
};
__device__ __forceinline__ void phase2(const MP& p, LAS unsigned char* lds) {
  pg8::Gemm g{(const bf16_t*)(p.ws + WS_U), (const bf16_t*)(p.ws + WS_WINT), MROWS, 2048, 1024};
  pg8::StaticOrder S; S.init(MROWS, 2048, gridDim.x, blockIdx.x);
  EpiIn E{p.ws};
  pg8::gemm_phase<EpiIn, pg8::StaticOrder, true, true>(lds, g, S, E);
}

__global__ void bridge1_k(const unsigned char* ws, float* pn, int b) {
  const int r = blockIdx.x; const int gr = grow(b, r);
  const bf16_t* QG = (const bf16_t*)(ws + WS_QG); const bf16_t* KG = (const bf16_t*)(ws + WS_KG); const bf16_t* VG = (const bf16_t*)(ws + WS_VG);
  const bf16_t* RG = (const bf16_t*)(ws + WS_RG); const bf16_t* A2 = (const bf16_t*)(ws + WS_A2); const float* KR = (const float*)(ws + WS_KR); const float* GFB = (const float*)(ws + WS_GFB);
  for (int c = threadIdx.x; c < 1984; c += 256) { float v;
    if (c < 256) v = bf2f(QG[(size_t)gr * 256 + c]);
    else if (c < 512) v = bf2f(KG[(size_t)gr * 256 + c - 256]);
    else if (c < 1024) v = bf2f(VG[(size_t)gr * 512 + c - 512]);
    else if (c < 1056) v = GFB[(size_t)gr * 32 + c - 1024];
    else if (c < 1568) v = bf2f(RG[(size_t)gr * 512 + c - 1056]);
    else if (c < 1824) v = bf2f(A2[(size_t)gr * 384 + c - 1568]);
    else if (c < 1952) v = bf2f(A2[(size_t)gr * 384 + 256 + c - 1824]);
    else { const int j = c - 1952; int jp = 0; for (int q = 0; q < 32; ++q) if (rope_unperm(q) == j) jp = q; v = KR[(size_t)gr * 32 + jp]; }
    pn[(size_t)r * 1984 + c] = v; }
}
}
namespace mk {
__device__ __forceinline__ float logsig_f(float x) { return fminf(x, 0.f) - __logf(1.f + __expf(-fabsf(x))); }
__device__ __forceinline__ int chunk_row0(int u) { return u < 512 ? u * 64 : NLAT + (u - 512) * 64; }

__device__ __forceinline__ void phase3(const MP& p, LAS unsigned char* lds) {
  const int tid = threadIdx.x; unsigned char* ws = p.ws;
  const bf16_t* A2 = (const bf16_t*)(ws + WS_A2); const float* KR = (const float*)(ws + WS_KR); const float* GFB = (const float*)(ws + WS_GFB);
  float* RS = (float*)(ws + WS_RS); const float* rope = (const float*)(ws + WS_ROPE); bf16_t* KC = (bf16_t*)(ws + WS_KC);
  float* LGF = (float*)(ws + WS_LGF); float* LGB = (float*)(ws + WS_LGB);
  LAS float* gl = (LAS float*)lds;
  const int gcol = tid & 255, gdir = tid >> 8;
  float gw[16];
  { const float* W = gdir ? p.in[I_WGKB] : p.in[I_WGKF];
#pragma unroll
    for (int i = 0; i < 16; ++i) gw[i] = W[i * 256 + gcol]; }
  const float gbias = (gdir ? p.in[I_BGKB] : p.in[I_BGKF])[gcol];
  for (int u = blockIdx.x; u < 544; u += gridDim.x) {
    const int r0 = chunk_row0(u); const bool lat = u < 512;
    { const int row = tid >> 3, c4 = (tid & 7) * 4; *(LAS f32x4*)(gl + row * 32 + c4) = *(const f32x4*)(GFB + (size_t)(r0 + row) * 32 + c4); }
    { const int row = tid >> 3, seg = tid & 7; const bf16_t* ar = A2 + (size_t)(r0 + row) * 384; float sq = 0.f, skv = 0.f;
#pragma unroll
      for (int i = 0; i < 4; ++i) { const u32x4 w = *(const u32x4*)(ar + seg * 32 + i * 8);
        sq += bflo(w.x) * bflo(w.x) + bfhi(w.x) * bfhi(w.x) + bflo(w.y) * bflo(w.y) + bfhi(w.y) * bfhi(w.y) + bflo(w.z) * bflo(w.z) + bfhi(w.z) * bfhi(w.z) + bflo(w.w) * bflo(w.w) + bfhi(w.w) * bfhi(w.w); }
#pragma unroll
      for (int i = 0; i < 2; ++i) { const u32x4 w = *(const u32x4*)(ar + 256 + seg * 16 + i * 8);
        skv += bflo(w.x) * bflo(w.x) + bfhi(w.x) * bfhi(w.x) + bflo(w.y) * bflo(w.y) + bfhi(w.y) * bfhi(w.y) + bflo(w.z) * bflo(w.z) + bfhi(w.z) * bfhi(w.z) + bflo(w.w) * bflo(w.w) + bfhi(w.w) * bfhi(w.w); }
      sq += __shfl_xor(sq, 1); sq += __shfl_xor(sq, 2); sq += __shfl_xor(sq, 4);
      skv += __shfl_xor(skv, 1); skv += __shfl_xor(skv, 2); skv += __shfl_xor(skv, 4);
      if (seg == 0) { RS[(size_t)(r0 + row) * 2] = rsqrtf(sq * (1.f / 256.f) + EPS); RS[(size_t)(r0 + row) * 2 + 1] = rsqrtf(skv * (1.f / 128.f) + EPS); } }
    { const int row = tid >> 3, h = tid & 7; const int gr = r0 + row; const float* kr = KR + (size_t)gr * 32; const float* rp = rope + (size_t)(gr & 4095) * 32;
      bf16_t* dst = KC + ((size_t)gr * 8 + h) * 96 + 64;
#pragma unroll
      for (int q = 0; q < 4; ++q) { const f32x4 a = *(const f32x4*)(kr + q * 8), b = *(const f32x4*)(kr + q * 8 + 4);
        f32x4 oa = a, ob = b;
        if (lat) { const f32x4 c0 = *(const f32x4*)(rp + q * 8), c1 = *(const f32x4*)(rp + q * 8 + 4);
          oa[0] = a[0] * c0[0] - a[1] * c0[1]; oa[1] = a[1] * c0[0] + a[0] * c0[1]; oa[2] = a[2] * c0[2] - a[3] * c0[3]; oa[3] = a[3] * c0[2] + a[2] * c0[3];
          ob[0] = b[0] * c1[0] - b[1] * c1[1]; ob[1] = b[1] * c1[0] + b[0] * c1[1]; ob[2] = b[2] * c1[2] - b[3] * c1[3]; ob[3] = b[3] * c1[2] + b[2] * c1[3]; }
        u32x4 w; w.x = cvt_pk(oa[0], oa[1]); w.y = cvt_pk(oa[2], oa[3]); w.z = cvt_pk(ob[0], ob[1]); w.w = cvt_pk(ob[2], ob[3]);
        *(u32x4*)(dst + q * 8) = w; } }
    __syncthreads();
    { float run = 0.f; float* out = gdir ? LGB : LGF;
#pragma unroll 8
      for (int i = 0; i < 64; ++i) { const int r = gdir ? 63 - i : i; float a = gbias;
#pragma unroll
        for (int j = 0; j < 16; ++j) a += gl[r * 32 + gdir * 16 + j] * gw[j];
        run += logsig_f(a) * (1.f / 16.f);
        out[(size_t)(r0 + r) * 256 + gcol] = run; } }
    __syncthreads();
  }
}

struct EpiUp {
  static constexpr bool PERM = true, AFTER_DRAIN = false;
  unsigned char* ws;
  __device__ __forceinline__ void operator()(const f32x4 (&acc)[2][2][4][2], const pg8::Unit& u, int wr, int wc, int fr, int fq) const {
    asm volatile("" : "+v"(fr), "+v"(fq));
    const unsigned row0 = u.pm * 256 + wr * 64 + fr; const int pn = u.pn;
    if (pn < 3) {
#pragma unroll
      for (int bj = 0; bj < 2; ++bj) {
        const unsigned c = pn * 256 + bj * 128 + wc * 32 + 8 * fq; const unsigned h = c / 96u, dp = c - h * 96u; const bool rot = dp >= 64u;
        const unsigned ro = rot ? dp - 64u : 0u;
#pragma unroll
        for (int ai = 0; ai < 2; ++ai)
#pragma unroll
          for (int m = 0; m < 4; ++m) {
            const unsigned row = row0 + ai * 128 + m * 16;
            if (row < (unsigned)NLAT) {
              const float rs = *(const float*)(ws + (unsigned)(WS_RS + row * 8u)) * QSCALE;
              f32x4 v0 = acc[ai][bj][m][0], v1 = acc[ai][bj][m][1];
              const unsigned roff = (unsigned)WS_ROPE + ((row & 4095u) * 32u + ro) * 4u;
              f32x4 c0 = *(const f32x4*)(ws + roff), c1 = *(const f32x4*)(ws + roff + 16u);
              if (!rot) { c0 = (f32x4){1.f, 0.f, 1.f, 0.f}; c1 = c0; }
              const f32x4 a = v0, b = v1;
              v0[0] = a[0] * c0[0] - a[1] * c0[1]; v0[1] = a[1] * c0[0] + a[0] * c0[1]; v0[2] = a[2] * c0[2] - a[3] * c0[3]; v0[3] = a[3] * c0[2] + a[2] * c0[3];
              v1[0] = b[0] * c1[0] - b[1] * c1[1]; v1[1] = b[1] * c1[0] + b[0] * c1[1]; v1[2] = b[2] * c1[2] - b[3] * c1[3]; v1[3] = b[3] * c1[2] + b[2] * c1[3];
              v0 = v0 * rs; v1 = v1 * rs;
              u32x4 w; w.x = cvt_pk(v0[0], v0[1]); w.y = cvt_pk(v0[2], v0[3]); w.z = cvt_pk(v1[0], v1[1]); w.w = cvt_pk(v1[2], v1[3]);
              *(u32x4*)(ws + (unsigned)(WS_QC + ((row * 8u + h) * 96u + dp) * 2u)) = w;
            }
            asm volatile("" ::: "memory");
          }
      }
    } else {
#pragma unroll
      for (int bj = 0; bj < 2; ++bj) {
        const unsigned c = (pn - 3) * 256 + bj * 128 + wc * 32 + 8 * fq; const unsigned h = c >> 7, d = c & 127u;
        const unsigned dbase = d < 64u ? (unsigned)WS_KC + (h * 96u + d) * 2u : (unsigned)WS_VC + (h * 64u + (d - 64u)) * 2u; const unsigned ldb = d < 64u ? 1536u : 1024u;
#pragma unroll
        for (int ai = 0; ai < 2; ++ai)
#pragma unroll
          for (int m = 0; m < 4; ++m) {
            const unsigned row = row0 + ai * 128 + m * 16; const float rs = *(const float*)(ws + (unsigned)(WS_RS + row * 8u + 4u));
            const f32x4 v0 = acc[ai][bj][m][0] * rs, v1 = acc[ai][bj][m][1] * rs;
            u32x4 w; w.x = cvt_pk(v0[0], v0[1]); w.y = cvt_pk(v0[2], v0[3]); w.z = cvt_pk(v1[0], v1[1]); w.w = cvt_pk(v1[2], v1[3]);
            *(u32x4*)(ws + (dbase + row * ldb)) = w;
            asm volatile("" ::: "memory");
          }
      }
    }
  }
};
__device__ __forceinline__ void phase4_gemm(const MP& p, LAS unsigned char* lds) {
  int K = 384; asm volatile("" : "+s"(K));
  pg8::Gemm g{(const bf16_t*)(p.ws + WS_A2), (const bf16_t*)(p.ws + WS_WUPT), MROWS, 1792, K};
  pg8::StaticOrder S; S.init(MROWS, 1792, gridDim.x, blockIdx.x);
  EpiUp E{p.ws};
  pg8::gemm_phase<EpiUp, pg8::StaticOrder, true, true>(lds, g, S, E);
}

__global__ void bridge2a_k(const unsigned char* ws, float* Qc, float* Kc, float* kv, int b) {
  const int r = blockIdx.x; const int gr = grow(b, r);
  const bf16_t* QC = (const bf16_t*)(ws + WS_QC); const bf16_t* KC = (const bf16_t*)(ws + WS_KC); const bf16_t* VC = (const bf16_t*)(ws + WS_VC);
  for (int e = threadIdx.x; e < 768; e += 256) {
    Kc[(size_t)r * 768 + e] = bf2f(KC[(size_t)gr * 768 + e]);
    if (r < SEQ) Qc[(size_t)r * 768 + e] = bf2f(QC[(size_t)gr * 768 + e]) * (1.f / 1.4426950408889634f) * 9.797958971132712f;
  }
  for (int e = threadIdx.x; e < 512; e += 256) { const int h = e >> 6, d = e & 63; kv[(size_t)r * 1024 + h * 128 + 64 + d] = bf2f(VC[(size_t)gr * 512 + e]); }
}
}
namespace mk {
namespace att {
typedef short s16x4 __attribute__((ext_vector_type(4)));
constexpr int NW = 8, QBLK = 32, KVBLK = 64, NT = 68;
constexpr int KROWB = 208;
constexpr int SHM_K = KVBLK * KROWB;
constexpr int SHM_V = KVBLK * 64 * 2;
constexpr int LDS_V = 0, LDS_K = 2 * SHM_V, LDS_WS = LDS_K + 2 * SHM_K, LDS_ATT = LDS_WS + NW * 64 * 4;
constexpr float THR = 8.f;
#define SBAR() __builtin_amdgcn_sched_barrier(0)
__device__ __forceinline__ int crow(int r, int hi) { return (r & 3) + 8 * (r >> 2) + 4 * hi; }

__device__ __forceinline__ void partialSM(f32x16& p0, f32x16& p1, float& m_reg, float& mn, float& alpha) {
  float pmax = p0[0];
#pragma unroll
  for (int r = 1; r < 16; ++r) pmax = fmaxf(pmax, p0[r]);
#pragma unroll
  for (int r = 0; r < 16; ++r) pmax = fmaxf(pmax, p1[r]);
  { auto rr = __builtin_amdgcn_permlane32_swap(__float_as_uint(pmax), __float_as_uint(pmax), false, false);
    pmax = fmaxf(__uint_as_float(rr[0]), __uint_as_float(rr[1])); }
  if (__builtin_expect(__all(pmax - m_reg <= THR), 1)) { mn = m_reg; alpha = 1.f; }
  else { mn = fmaxf(m_reg, pmax); alpha = __builtin_amdgcn_exp2f(m_reg - mn); m_reg = mn; }
#pragma unroll
  for (int r = 0; r < 16; ++r) p0[r] = p0[r] - mn;
#pragma unroll
  for (int r = 0; r < 16; ++r) p1[r] = p1[r] - mn;
#pragma unroll
  for (int r = 0; r < 16; ++r) p0[r] = __builtin_amdgcn_exp2f(p0[r]);
}
__device__ __forceinline__ void finishSM(f32x16& p0, f32x16& p1, float alpha, float& l_reg, bf16x8& pa0, bf16x8& pa1, bf16x8& pa2, bf16x8& pa3) {
#pragma unroll
  for (int r = 0; r < 16; ++r) p1[r] = __builtin_amdgcn_exp2f(p1[r]);
  float ps = 0;
#pragma unroll
  for (int r = 0; r < 16; ++r) ps += p0[r];
#pragma unroll
  for (int r = 0; r < 16; ++r) ps += p1[r];
  { auto rr = __builtin_amdgcn_permlane32_swap(__float_as_uint(ps), __float_as_uint(ps), false, false);
    ps = __uint_as_float(rr[0]) + __uint_as_float(rr[1]); }
  l_reg = l_reg * alpha + ps;
#define PK4(P, BASE, OUT) do { unsigned a0 = cvt_pk(P[BASE + 0], P[BASE + 1]), a1 = cvt_pk(P[BASE + 2], P[BASE + 3]);   \
    unsigned b0 = cvt_pk(P[BASE + 4], P[BASE + 5]), b1 = cvt_pk(P[BASE + 6], P[BASE + 7]);                              \
    auto r0 = __builtin_amdgcn_permlane32_swap(a0, b0, false, false); auto r1 = __builtin_amdgcn_permlane32_swap(a1, b1, false, false); \
    u32x4 w = {r0[0], r1[0], r0[1], r1[1]}; OUT = __builtin_bit_cast(bf16x8, w); } while (0)
  PK4(p0, 0, pa0); PK4(p0, 8, pa1); PK4(p1, 0, pa2); PK4(p1, 8, pa3);
#undef PK4
}
__device__ __forceinline__ void qkt(f32x16& p0, f32x16& p1, const LAS unsigned char* Ks, const bf16x8* qr, int r32, int hi) {
  p0 = f32x16{}; p1 = f32x16{};
#pragma unroll
  for (int d0 = 0; d0 < 6; ++d0) { const int cb = (d0 * 16 + hi * 8) * 2;
    const bf16x8 b0 = *(const LAS bf16x8*)(Ks + r32 * KROWB + cb);
    const bf16x8 b1 = *(const LAS bf16x8*)(Ks + (32 + r32) * KROWB + cb);
    p0 = __builtin_amdgcn_mfma_f32_32x32x16_bf16(b0, qr[d0], p0, 0, 0, 0);
    p1 = __builtin_amdgcn_mfma_f32_32x32x16_bf16(b1, qr[d0], p1, 0, 0, 0); }
}
__device__ __forceinline__ int v_st(int k, int c) { const int kk = (k & ~0xC) | ((k & 4) << 1) | ((k & 8) >> 1); return ((kk >> 3) * 2 + (c >> 5)) * 512 + ((kk & 7) * 32 + (c & 31)) * 2; }
__device__ __forceinline__ int v_rd_base(int lane) { return ((lane & 3) << 3) | (((lane >> 2) & 3) << 6) | (((lane >> 4) & 1) << 5) | (((lane >> 5) & 1) << 8); }
constexpr int v_rd_off(int d0, int ks, int half) { return d0 * 512 + ks * 2048 + half * 1024; }
template <int OFF> __device__ __forceinline__ s16x4 tr_read(int vb) {
  s16x4 r; asm volatile("ds_read_b64_tr_b16 %0, %1 offset:%2" : "=&v"(r) : "v"(vb), "i"(OFF) : "memory"); return r;
}
template <int D0> __device__ __forceinline__ void pv_one(f32x16& od, int vb, bf16x8 pa0, bf16x8 pa1, bf16x8 pa2, bf16x8 pa3) {
  const s16x4 l0 = tr_read<v_rd_off(D0, 0, 0)>(vb), h0 = tr_read<v_rd_off(D0, 0, 1)>(vb), l1 = tr_read<v_rd_off(D0, 1, 0)>(vb), h1 = tr_read<v_rd_off(D0, 1, 1)>(vb);
  const s16x4 l2 = tr_read<v_rd_off(D0, 2, 0)>(vb), h2 = tr_read<v_rd_off(D0, 2, 1)>(vb), l3 = tr_read<v_rd_off(D0, 3, 0)>(vb), h3 = tr_read<v_rd_off(D0, 3, 1)>(vb);
  asm volatile("s_waitcnt lgkmcnt(0)" ::: "memory"); SBAR();
#define PK(L, H) (bf16x8){L[0], L[1], L[2], L[3], H[0], H[1], H[2], H[3]}
  od = __builtin_amdgcn_mfma_f32_32x32x16_bf16(pa0, PK(l0, h0), od, 0, 0, 0);
  od = __builtin_amdgcn_mfma_f32_32x32x16_bf16(pa1, PK(l1, h1), od, 0, 0, 0);
  od = __builtin_amdgcn_mfma_f32_32x32x16_bf16(pa2, PK(l2, h2), od, 0, 0, 0);
  od = __builtin_amdgcn_mfma_f32_32x32x16_bf16(pa3, PK(l3, h3), od, 0, 0, 0);
#undef PK
}
__device__ __forceinline__ void pv_d0(f32x16* o, int vb, bf16x8 pa0, bf16x8 pa1, bf16x8 pa2, bf16x8 pa3) {
  pv_one<0>(o[0], vb, pa0, pa1, pa2, pa3); pv_one<1>(o[1], vb, pa0, pa1, pa2, pa3);
}

__device__ __forceinline__ void attn_unit(const bf16_t* __restrict__ QC, const bf16_t* __restrict__ KC, const bf16_t* __restrict__ VC, bf16_t* __restrict__ MIX,
                                          int b, int h, int qb, LAS unsigned char* lds) {
  const int tid = threadIdx.x, wid = tid >> 6, lane = tid & 63, r32 = lane & 31, hi = lane >> 5;
  LAS unsigned char* V_lds = lds + LDS_V; LAS unsigned char* K_lds = lds + LDS_K;
  LAS float* wsf = (LAS float*)(lds + LDS_WS) + wid * 64; LAS float* li_l = wsf; LAS float* al_l = wsf + 32;
  float m_reg = -1e30f, l_reg = 0; f32x16 o[2] = {}; bf16x8 qr[6];
  const int qrow = b * SEQ + qb * 256 + wid * QBLK + r32;
  const bf16_t* Qw = QC + ((size_t)qrow * 8 + h) * 96 + hi * 8;
#pragma unroll
  for (int d0 = 0; d0 < 6; ++d0) qr[d0] = *(const bf16x8*)(Qw + d0 * 16);
  const int sr = tid >> 3, sc = (tid & 7) * 8, vst = v_st(sr, sc);
  const int k0r = tid / 12, k0c = tid - k0r * 12; const int id1 = 512 + (tid & 255); const int k1r = id1 / 12, k1c = id1 - k1r * 12; const bool w1 = tid < 256;
  const int kst0 = k0r * KROWB + k0c * 16, kst1 = k1r * KROWB + k1c * 16;
  const int vb0 = (int)(unsigned)(size_t)V_lds + v_rd_base(lane);
  const bf16_t* Kh = KC + (size_t)h * 96; const bf16_t* Vh = VC + (size_t)h * 64;
  struct { bf16x8 vs, ks0, ks1; } sr_[2];
#define TROW(j) ((j) < 64 ? b * SEQ + (j) * 64 : NLAT + b * CTXL + ((j) - 64) * 64)
#define SLOAD(i, j) do { const int tr_ = TROW(j); sr_[i].vs = *(const bf16x8*)(Vh + (size_t)(tr_ + sr) * 512 + sc); \
    sr_[i].ks0 = *(const bf16x8*)(Kh + (size_t)(tr_ + k0r) * 768 + k0c * 8); sr_[i].ks1 = *(const bf16x8*)(Kh + (size_t)(tr_ + k1r) * 768 + k1c * 8); } while (0)
#define SWRITE(bb, i) do { *(LAS bf16x8*)(V_lds + (bb) * SHM_V + vst) = sr_[i].vs; *(LAS bf16x8*)(K_lds + (bb) * SHM_K + kst0) = sr_[i].ks0; \
    if (w1) *(LAS bf16x8*)(K_lds + (bb) * SHM_K + kst1) = sr_[i].ks1; } while (0)
#define SWAIT() asm volatile("s_waitcnt vmcnt(3)" ::: "memory")
#define RESC(a) do { if (__any((a) < 1.f)) { if (hi == 0) al_l[r32] = (a); asm volatile("s_waitcnt lgkmcnt(0)" ::: "memory"); \
    _Pragma("unroll") for (int d = 0; d < 2; ++d) _Pragma("unroll") for (int r = 0; r < 16; ++r) o[d][r] *= al_l[crow(r, hi)]; } } while (0)
  f32x16 pA0, pA1, pB0, pB1; float mnA, mnB, alA, alB; bf16x8 pa0, pa1, pa2, pa3;
  constexpr int SE = 0, SO = 1;
  SLOAD(SE, 0); asm volatile("s_waitcnt vmcnt(0)" ::: "memory"); SWRITE(0, SE); __syncthreads();
  qkt(pA0, pA1, K_lds, qr, r32, hi); partialSM(pA0, pA1, m_reg, mnA, alA);
  SLOAD(SO, 1); SLOAD(SE, 2);
  SWAIT(); SWRITE(1, SO); __syncthreads();
  for (int j = 1; j + 1 < NT; j += 2) {
    SBAR(); qkt(pB0, pB1, K_lds + SHM_K, qr, r32, hi);
    finishSM(pA0, pA1, alA, l_reg, pa0, pa1, pa2, pa3); SBAR();
    SLOAD(SO, j + 2); SBAR();
    pv_d0(o, vb0, pa0, pa1, pa2, pa3); partialSM(pB0, pB1, m_reg, mnB, alB);
    __syncthreads(); SWAIT(); SWRITE(0, SE);
    RESC(alB); __syncthreads();
    SBAR(); qkt(pA0, pA1, K_lds, qr, r32, hi);
    finishSM(pB0, pB1, alB, l_reg, pa0, pa1, pa2, pa3); SBAR();
    if (j + 3 < NT) SLOAD(SE, j + 3); SBAR();
    pv_d0(o, vb0 + SHM_V, pa0, pa1, pa2, pa3); partialSM(pA0, pA1, m_reg, mnA, alA);
    __syncthreads(); SWAIT(); SWRITE(1, SO);
    RESC(alA); __syncthreads();
  }
  SBAR(); qkt(pB0, pB1, K_lds + SHM_K, qr, r32, hi);
  finishSM(pA0, pA1, alA, l_reg, pa0, pa1, pa2, pa3); SBAR();
  pv_d0(o, vb0, pa0, pa1, pa2, pa3); partialSM(pB0, pB1, m_reg, mnB, alB);
  __syncthreads(); RESC(alB);
  finishSM(pB0, pB1, alB, l_reg, pa0, pa1, pa2, pa3); SBAR();
  pv_d0(o, vb0 + SHM_V, pa0, pa1, pa2, pa3);
  if (hi == 0) li_l[r32] = l_reg; asm volatile("s_waitcnt lgkmcnt(0)" ::: "memory");
  bf16_t* Ow = MIX + (size_t)(b * SEQ + qb * 256 + wid * QBLK) * 1024 + 512 + h * 64;
#pragma unroll
  for (int r = 0; r < 16; ++r) { const int orow = crow(r, hi); const float rl = __builtin_amdgcn_rcpf(li_l[orow]);
#pragma unroll
    for (int d0 = 0; d0 < 2; ++d0) { const float v = o[d0][r] * rl; const unsigned w = cvt_pk(v, v); Ow[(size_t)orow * 1024 + d0 * 32 + r32] = (bf16_t)(w & 0xffffu); } }
  __syncthreads();
#undef TROW
#undef SLOAD
#undef SWRITE
#undef SWAIT
#undef RESC
}
}

__device__ __forceinline__ void phase5_attn(const MP& p, LAS unsigned char* lds) {
  const bf16_t* QC = (const bf16_t*)(p.ws + WS_QC); const bf16_t* KC = (const bf16_t*)(p.ws + WS_KC); const bf16_t* VC = (const bf16_t*)(p.ws + WS_VC);
  bf16_t* MIX = (bf16_t*)(p.ws + WS_MIX);
  const int bid = blockIdx.x, G = gridDim.x;
  if (G == 256) {
    const int xcd = bid & 7, slot = bid >> 3, bhl = slot >> 4, qb = slot & 15;
    for (int i = 0; i < 4; ++i) { const int bh = (i * 2 + bhl) * 8 + xcd; att::attn_unit(QC, KC, VC, MIX, bh >> 3, bh & 7, qb, lds); }
  } else {
    for (int u = bid; u < 1024; u += G) { const int bh = u >> 4, qb = u & 15; att::attn_unit(QC, KC, VC, MIX, bh >> 3, bh & 7, qb, lds); }
  }
}

__global__ void bridge2b_k(const unsigned char* ws, float* mix, int b, int c0, int c1) {
  const int r = blockIdx.x; const bf16_t* MIX = (const bf16_t*)(ws + WS_MIX);
  for (int c = c0 + threadIdx.x; c < c1; c += 256) mix[(size_t)r * 1024 + c] = bf2f(MIX[(size_t)(b * SEQ + r) * 1024 + c]);
}
}
namespace mk {
namespace gla {
constexpr int RS144 = 144;
constexpr int L_VT = 0;
constexpr int L_K1 = 18432, L_K2 = L_K1 + 9216;
constexpr int L_O = L_K2 + 9216;
constexpr int OST = 132;
__device__ __forceinline__ int crow(int r, int hi) { return (r & 3) + 8 * (r >> 2) + 4 * hi; }
__device__ __forceinline__ int cid_row0(int b, int cid) { return cid < 4 ? NLAT + b * CTXL + cid * 64 : b * SEQ + (cid - 4) * 64; }
__device__ __forceinline__ size_t ds_off(int b, int h, int dir, int cid) { return ((size_t)(((b * 4 + h) * 2 + dir) * 68 + cid)) * 8192; }

__device__ __forceinline__ void stage_vt(const bf16_t* VG, int row0, int h, LAS unsigned char* vt) {
  const int tid = threadIdx.x;
#pragma unroll
  for (int i = 0; i < 2; ++i) { const int ch = tid + i * 512, j = ch >> 4, v0 = (ch & 15) * 8;
    const u32x4 w = *(const u32x4*)(VG + (size_t)(row0 + j) * 512 + h * 128 + v0);
    LAS unsigned short* d = (LAS unsigned short*)(vt + v0 * RS144 + j * 2);
    d[0 * 72] = (unsigned short)(w.x & 0xffff); d[1 * 72] = (unsigned short)(w.x >> 16); d[2 * 72] = (unsigned short)(w.y & 0xffff); d[3 * 72] = (unsigned short)(w.y >> 16);
    d[4 * 72] = (unsigned short)(w.z & 0xffff); d[5 * 72] = (unsigned short)(w.z >> 16); d[6 * 72] = (unsigned short)(w.w & 0xffff); d[7 * 72] = (unsigned short)(w.w >> 16); }
}

__device__ __forceinline__ void stage1_unit(const MP& p, int b, int h, int cid, LAS unsigned char* lds) {
  const int tid = threadIdx.x, wid = tid >> 6, lane = tid & 63, r32 = lane & 31, hi = lane >> 5;
  unsigned char* ws = p.ws; const bf16_t* KG = (const bf16_t*)(ws + WS_KG); const bf16_t* VG = (const bf16_t*)(ws + WS_VG);
  const float* LGF = (const float*)(ws + WS_LGF); const float* LGB = (const float*)(ws + WS_LGB); bf16_t* DS = (bf16_t*)(ws + WS_DS);
  const int row0 = cid_row0(b, cid);
  stage_vt(VG, row0, h, lds + L_VT);
  { const int j = tid >> 3, k0 = (tid & 7) * 8; const u32x4 kw = *(const u32x4*)(KG + (size_t)(row0 + j) * 256 + h * 64 + k0);
    const float* bf = LGF + (size_t)(row0 + j) * 256 + h * 64 + k0; const float* bfe = LGF + (size_t)(row0 + 63) * 256 + h * 64 + k0;
    const float* bb = LGB + (size_t)(row0 + j) * 256 + h * 64 + k0; const float* bbe = LGB + (size_t)row0 * 256 + h * 64 + k0;
    const f32x4 f0 = *(const f32x4*)bf, f1 = *(const f32x4*)(bf + 4), fe0 = *(const f32x4*)bfe, fe1 = *(const f32x4*)(bfe + 4);
    const f32x4 g0 = *(const f32x4*)bb, g1 = *(const f32x4*)(bb + 4), ge0 = *(const f32x4*)bbe, ge1 = *(const f32x4*)(bbe + 4);
    float kv[8] = {bflo(kw.x), bfhi(kw.x), bflo(kw.y), bfhi(kw.y), bflo(kw.z), bfhi(kw.z), bflo(kw.w), bfhi(kw.w)};
    float ef[8] = {fe0[0] - f0[0], fe0[1] - f0[1], fe0[2] - f0[2], fe0[3] - f0[3], fe1[0] - f1[0], fe1[1] - f1[1], fe1[2] - f1[2], fe1[3] - f1[3]};
    float eb[8] = {ge0[0] - g0[0], ge0[1] - g0[1], ge0[2] - g0[2], ge0[3] - g0[3], ge1[0] - g1[0], ge1[1] - g1[1], ge1[2] - g1[2], ge1[3] - g1[3]};
    LAS unsigned short* d1 = (LAS unsigned short*)(lds + L_K1 + k0 * RS144 + j * 2); LAS unsigned short* d2 = (LAS unsigned short*)(lds + L_K2 + k0 * RS144 + j * 2);
#pragma unroll
    for (int i = 0; i < 8; ++i) { const float a = kv[i] * __expf(ef[i]), c = kv[i] * __expf(eb[i]);
      d1[i * 72] = (unsigned short)(cvt_pk(a, a) & 0xffff); d2[i * 72] = (unsigned short)(cvt_pk(c, c) & 0xffff); } }
  __syncthreads();
  { const int dir = wid >> 2, mt = wid & 3;
    const LAS unsigned char* vt = lds + L_VT + (mt * 32 + r32) * RS144 + hi * 16; const LAS unsigned char* kd = lds + (dir ? L_K2 : L_K1) + r32 * RS144 + hi * 16;
    f32x16 acc0 = {}, acc1 = {};
#pragma unroll
    for (int s = 0; s < 4; ++s) { const bf16x8 a = *(const LAS bf16x8*)(vt + s * 32);
      const bf16x8 b0 = *(const LAS bf16x8*)(kd + s * 32), b1 = *(const LAS bf16x8*)(kd + 32 * RS144 + s * 32);
      acc0 = __builtin_amdgcn_mfma_f32_32x32x16_bf16(a, b0, acc0, 0, 0, 0); acc1 = __builtin_amdgcn_mfma_f32_32x32x16_bf16(a, b1, acc1, 0, 0, 0); }
    bf16_t* out = DS + ds_off(b, h, dir, cid);
#pragma unroll
    for (int r = 0; r < 16; ++r) { const int v = mt * 32 + crow(r, hi);
      out[v * 64 + r32] = (bf16_t)(cvt_pk(acc0[r], acc0[r]) & 0xffff); out[v * 64 + 32 + r32] = (bf16_t)(cvt_pk(acc1[r], acc1[r]) & 0xffff); } }
  __syncthreads();
}
__device__ __forceinline__ void stage1(const MP& p, LAS unsigned char* lds) {
  for (int u = blockIdx.x; u < 8 * 4 * 68; u += gridDim.x) { const int cid = u % 68, bh = u / 68; stage1_unit(p, bh >> 2, bh & 3, cid, lds); }
}

__device__ __forceinline__ void stage2(const MP& p) {
  unsigned char* ws = p.ws; const float* LGF = (const float*)(ws + WS_LGF); const float* LGB = (const float*)(ws + WS_LGB); bf16_t* DS = (bf16_t*)(ws + WS_DS);
  for (int e = blockIdx.x * NTH + threadIdx.x; e < 131072; e += gridDim.x * NTH) {
    const int k4 = (e & 15) * 4, v = (e >> 4) & 127, seq = e >> 11, dir = seq & 1, h = (seq >> 1) & 3, b = seq >> 3;
    const float* LG = dir ? LGB : LGF;
    float s0 = 0.f, s1 = 0.f, s2 = 0.f, s3 = 0.f;
    for (int n0 = 0; n0 < 68; n0 += 4) {
      u32x2 dsv[4]; f32x4 lg[4]; bf16_t* ptr[4];
#pragma unroll
      for (int i = 0; i < 4; ++i) { const int n = n0 + i; const int cid = dir ? (n < 4 ? 3 - n : 71 - n) : n;
        const int row0 = cid_row0(b, cid); ptr[i] = DS + ds_off(b, h, dir, cid) + v * 64 + k4;
        dsv[i] = *(const u32x2*)ptr[i]; lg[i] = *(const f32x4*)(LG + (size_t)(row0 + (dir ? 0 : 63)) * 256 + h * 64 + k4); }
#pragma unroll
      for (int i = 0; i < 4; ++i) { u32x2 o; o.x = cvt_pk(s0, s1); o.y = cvt_pk(s2, s3); *(u32x2*)ptr[i] = o;
        s0 = __expf(lg[i][0]) * s0 + bflo(dsv[i].x); s1 = __expf(lg[i][1]) * s1 + bfhi(dsv[i].x); s2 = __expf(lg[i][2]) * s2 + bflo(dsv[i].y); s3 = __expf(lg[i][3]) * s3 + bfhi(dsv[i].y); }
    }
  }
}

__device__ __forceinline__ void stage3_unit(const MP& p, int b, int h, int c, LAS unsigned char* lds) {
  const int tid = threadIdx.x, wid = tid >> 6, lane = tid & 63, r32 = lane & 31, hi = lane >> 5;
  unsigned char* ws = p.ws; const bf16_t* QG = (const bf16_t*)(ws + WS_QG); const bf16_t* KG = (const bf16_t*)(ws + WS_KG); const bf16_t* VG = (const bf16_t*)(ws + WS_VG);
  const bf16_t* RG = (const bf16_t*)(ws + WS_RG); const float* LGF = (const float*)(ws + WS_LGF); const float* LGB = (const float*)(ws + WS_LGB);
  const bf16_t* DS = (const bf16_t*)(ws + WS_DS); bf16_t* MIX = (bf16_t*)(ws + WS_MIX);
  const int row0 = b * SEQ + c * 64, cid = c + 4;
  stage_vt(VG, row0, h, lds + L_VT);
  { const int j = tid >> 3, k0 = (tid & 7) * 8; const u32x4 kw = *(const u32x4*)(KG + (size_t)(row0 + j) * 256 + h * 64 + k0);
    const float* bf = LGF + (size_t)(row0 + j) * 256 + h * 64 + k0; const float* bb = LGB + (size_t)(row0 + j) * 256 + h * 64 + k0;
    const f32x4 f0 = *(const f32x4*)bf, f1 = *(const f32x4*)(bf + 4), g0 = *(const f32x4*)bb, g1 = *(const f32x4*)(bb + 4);
    float kv[8] = {bflo(kw.x), bfhi(kw.x), bflo(kw.y), bfhi(kw.y), bflo(kw.z), bfhi(kw.z), bflo(kw.w), bfhi(kw.w)};
    float ef[8] = {f0[0], f0[1], f0[2], f0[3], f1[0], f1[1], f1[2], f1[3]}; float eb[8] = {g0[0], g0[1], g0[2], g0[3], g1[0], g1[1], g1[2], g1[3]};
    float a[8], cc[8];
#pragma unroll
    for (int i = 0; i < 8; ++i) { a[i] = kv[i] * __expf(-ef[i]); cc[i] = kv[i] * __expf(-eb[i]); }
    u32x4 w1, w2; w1.x = cvt_pk(a[0], a[1]); w1.y = cvt_pk(a[2], a[3]); w1.z = cvt_pk(a[4], a[5]); w1.w = cvt_pk(a[6], a[7]);
    w2.x = cvt_pk(cc[0], cc[1]); w2.y = cvt_pk(cc[2], cc[3]); w2.z = cvt_pk(cc[4], cc[5]); w2.w = cvt_pk(cc[6], cc[7]);
    *(LAS u32x4*)(lds + L_K1 + j * RS144 + k0 * 2) = w1; *(LAS u32x4*)(lds + L_K2 + j * RS144 + k0 * 2) = w2; }
  __syncthreads();
  { const int dir = wid >> 2, half = (wid >> 1) & 1, vh = wid & 1; const int i = half * 32 + r32;
    bf16x8 qr[4];
    { const bf16_t* qp = QG + (size_t)(row0 + i) * 256 + h * 64 + hi * 8; const float* bp = (dir ? LGB : LGF) + (size_t)(row0 + i) * 256 + h * 64 + hi * 8;
#pragma unroll
      for (int s = 0; s < 4; ++s) { const u32x4 qw = *(const u32x4*)(qp + s * 16); const f32x4 b0 = *(const f32x4*)(bp + s * 16), b1 = *(const f32x4*)(bp + s * 16 + 4);
        u32x4 w; w.x = cvt_pk(bflo(qw.x) * __expf(b0[0]) * 0.125f, bfhi(qw.x) * __expf(b0[1]) * 0.125f); w.y = cvt_pk(bflo(qw.y) * __expf(b0[2]) * 0.125f, bfhi(qw.y) * __expf(b0[3]) * 0.125f);
        w.z = cvt_pk(bflo(qw.z) * __expf(b1[0]) * 0.125f, bfhi(qw.z) * __expf(b1[1]) * 0.125f); w.w = cvt_pk(bflo(qw.w) * __expf(b1[2]) * 0.125f, bfhi(qw.w) * __expf(b1[3]) * 0.125f);
        qr[s] = __builtin_bit_cast(bf16x8, w); } }
    f32x16 p0 = {}, p1 = {};
    { const LAS unsigned char* ke = lds + (dir ? L_K2 : L_K1) + r32 * RS144 + hi * 16;
#pragma unroll
      for (int s = 0; s < 4; ++s) { const bf16x8 k0 = *(const LAS bf16x8*)(ke + s * 32), k1 = *(const LAS bf16x8*)(ke + 32 * RS144 + s * 32);
        p0 = __builtin_amdgcn_mfma_f32_32x32x16_bf16(k0, qr[s], p0, 0, 0, 0); p1 = __builtin_amdgcn_mfma_f32_32x32x16_bf16(k1, qr[s], p1, 0, 0, 0); } }
#pragma unroll
    for (int r = 0; r < 16; ++r) { const int j0 = crow(r, hi), j1 = 32 + j0;
      const bool k0 = dir ? (j0 >= i) : (j0 <= i), k1 = dir ? (j1 >= i) : (j1 <= i);
      p0[r] = k0 ? p0[r] : 0.f; p1[r] = k1 ? p1[r] : 0.f; }
    bf16x8 pa0, pa1, pa2, pa3;
#define PK4(P, BASE, OUT) do { unsigned a0 = cvt_pk(P[BASE + 0], P[BASE + 1]), a1 = cvt_pk(P[BASE + 2], P[BASE + 3]);   \
    unsigned b0 = cvt_pk(P[BASE + 4], P[BASE + 5]), b1 = cvt_pk(P[BASE + 6], P[BASE + 7]);                              \
    auto r0 = __builtin_amdgcn_permlane32_swap(a0, b0, false, false); auto r1 = __builtin_amdgcn_permlane32_swap(a1, b1, false, false); \
    u32x4 w = {r0[0], r1[0], r0[1], r1[1]}; OUT = __builtin_bit_cast(bf16x8, w); } while (0)
    PK4(p0, 0, pa0); PK4(p0, 8, pa1); PK4(p1, 0, pa2); PK4(p1, 8, pa3);
#undef PK4
    f32x16 o[2] = {};
    const bf16_t* sp = DS + ds_off(b, h, dir, cid);
#pragma unroll
    for (int d0 = 0; d0 < 2; ++d0) { const int v = vh * 64 + d0 * 32 + r32;
      const LAS unsigned char* vt = lds + L_VT + v * RS144 + hi * 16; const bf16_t* sv = sp + v * 64 + hi * 8;
      const bf16x8 v0 = *(const LAS bf16x8*)(vt), v1 = *(const LAS bf16x8*)(vt + 32), v2 = *(const LAS bf16x8*)(vt + 64), v3 = *(const LAS bf16x8*)(vt + 96);
      const bf16x8 s0 = *(const bf16x8*)(sv), s1 = *(const bf16x8*)(sv + 16), s2 = *(const bf16x8*)(sv + 32), s3 = *(const bf16x8*)(sv + 48);
      o[d0] = __builtin_amdgcn_mfma_f32_32x32x16_bf16(pa0, v0, o[d0], 0, 0, 0); o[d0] = __builtin_amdgcn_mfma_f32_32x32x16_bf16(pa1, v1, o[d0], 0, 0, 0);
      o[d0] = __builtin_amdgcn_mfma_f32_32x32x16_bf16(pa2, v2, o[d0], 0, 0, 0); o[d0] = __builtin_amdgcn_mfma_f32_32x32x16_bf16(pa3, v3, o[d0], 0, 0, 0);
      o[d0] = __builtin_amdgcn_mfma_f32_32x32x16_bf16(qr[0], s0, o[d0], 0, 0, 0); o[d0] = __builtin_amdgcn_mfma_f32_32x32x16_bf16(qr[1], s1, o[d0], 0, 0, 0);
      o[d0] = __builtin_amdgcn_mfma_f32_32x32x16_bf16(qr[2], s2, o[d0], 0, 0, 0); o[d0] = __builtin_amdgcn_mfma_f32_32x32x16_bf16(qr[3], s3, o[d0], 0, 0, 0); }
    LAS float* ob = (LAS float*)(lds + L_O) + dir * 64 * OST;
#pragma unroll
    for (int r = 0; r < 16; ++r) { const int row = half * 32 + crow(r, hi);
      ob[row * OST + vh * 64 + r32] = o[0][r]; ob[row * OST + vh * 64 + 32 + r32] = o[1][r]; } }
  __syncthreads();
  { const int row = tid >> 3, seg = tid & 7; const LAS float* of = (const LAS float*)(lds + L_O) + row * OST + seg * 16; const LAS float* obk = of + 64 * OST;
    float x[16]; float sq = 0.f;
#pragma unroll
    for (int q = 0; q < 4; ++q) { const f32x4 a = *(const LAS f32x4*)(of + q * 4), bq = *(const LAS f32x4*)(obk + q * 4);
#pragma unroll
      for (int t = 0; t < 4; ++t) { x[q * 4 + t] = a[t] + bq[t]; sq += x[q * 4 + t] * x[q * 4 + t]; } }
    sq += __shfl_xor(sq, 1); sq += __shfl_xor(sq, 2); sq += __shfl_xor(sq, 4);
    const float rstd = rsqrtf(sq * (1.f / 128.f) + EPS);
    const bf16_t* rp = RG + (size_t)(row0 + row) * 512 + h * 128 + seg * 16; const float* gp = p.in[I_GLAG] + seg * 16;
    const u32x4 r0 = *(const u32x4*)rp, r1 = *(const u32x4*)(rp + 8);
    const float rr[16] = {bflo(r0.x), bfhi(r0.x), bflo(r0.y), bfhi(r0.y), bflo(r0.z), bfhi(r0.z), bflo(r0.w), bfhi(r0.w), bflo(r1.x), bfhi(r1.x), bflo(r1.y), bfhi(r1.y), bflo(r1.z), bfhi(r1.z), bflo(r1.w), bfhi(r1.w)};
    float y[16];
#pragma unroll
    for (int t = 0; t < 16; ++t) y[t] = x[t] * rstd * gp[t] * (rr[t] / (1.f + __expf(-rr[t])));
    u32x4 w0, w1; w0.x = cvt_pk(y[0], y[1]); w0.y = cvt_pk(y[2], y[3]); w0.z = cvt_pk(y[4], y[5]); w0.w = cvt_pk(y[6], y[7]);
    w1.x = cvt_pk(y[8], y[9]); w1.y = cvt_pk(y[10], y[11]); w1.z = cvt_pk(y[12], y[13]); w1.w = cvt_pk(y[14], y[15]);
    bf16_t* dst = MIX + (size_t)(row0 + row) * 1024 + h * 128 + seg * 16; *(u32x4*)dst = w0; *(u32x4*)(dst + 8) = w1; }
  __syncthreads();
}
__device__ __forceinline__ void stage3(const MP& p, LAS unsigned char* lds) {
  for (int u = blockIdx.x; u < 8 * 4 * 64; u += gridDim.x) { const int c = u & 63, bh = u >> 6; stage3_unit(p, bh >> 2, bh & 3, c, lds); }
}
}
}
namespace mk {
constexpr int CW_NT = 32, CW_TB = 64;
constexpr int MAXT = 152;

__device__ __forceinline__ void prep_expert_weights(const MP& p, LAS unsigned char* lds) {
  LAS float* t = (LAS float*)lds; int cursor = 0;
  wprep(SrcW1{p.in[I_WEG], p.in[I_WEU]}, (bf16_t*)(p.ws + WS_W1T), 16 * 512, 1024, t, cursor);
  wprep(SrcW2{p.in[I_WED]}, (bf16_t*)(p.ws + WS_W2T), 24 * 1024, 512, t, cursor);
}

struct EpiOut {
  static constexpr bool PERM = false, AFTER_DRAIN = false;
  const float* x; float* out; unsigned char* ws;
  __device__ __forceinline__ void operator()(const f32x4 (&acc)[2][2][4][2], const pg8::Unit& u, int wr, int wc, int fr, int fq) const {
    asm volatile("" : "+v"(fr), "+v"(fq));
    const unsigned row0 = u.pm * 256 + wr * 64 + fr; const unsigned col0 = u.pn * 256 + wc * 32 + 4 * fq; const unsigned b = (u.pm * 256) >> 12;
    f32x4 gt[2][2];
#pragma unroll
    for (int bj = 0; bj < 2; ++bj)
#pragma unroll
      for (int n = 0; n < 2; ++n) gt[bj][n] = *(const f32x4*)(ws + (unsigned)(WS_MOD + (b * 6144u + 2048u + col0 + bj * 128 + n * 16) * 4u));
#pragma unroll
    for (int ai = 0; ai < 2; ++ai)
#pragma unroll
      for (int m = 0; m < 4; ++m) {
        const unsigned row = row0 + ai * 128 + m * 16; const unsigned eo = row * 1024u + col0; float s = 0.f, q = 0.f;
#pragma unroll
        for (int bj = 0; bj < 2; ++bj)
#pragma unroll
          for (int n = 0; n < 2; ++n) { const f32x4 xv = *(const f32x4*)(x + eo + bj * 128 + n * 16); const f32x4 z = xv * ALPHA + gt[bj][n] * acc[ai][bj][m][n];
            *(f32x4*)(out + eo + bj * 128 + n * 16) = z; s += (z[0] + z[1]) + (z[2] + z[3]); q += (z[0] * z[0] + z[1] * z[1]) + (z[2] * z[2] + z[3] * z[3]); }
        s += __shfl_xor(s, 16); s += __shfl_xor(s, 32); q += __shfl_xor(q, 16); q += __shfl_xor(q, 32);
        if (fq == 0) { f32x2 st = {s, q}; *(f32x2*)(ws + (unsigned)(WS_ST1 + (row * 16u + u.pn * 4u + wc) * 8u)) = st; }
        asm volatile("" ::: "memory");
      }
  }
};
__device__ __forceinline__ void phase7(const MP& p, LAS unsigned char* lds) {
  int K = 1024; asm volatile("" : "+s"(K));
  pg8::Gemm g{(const bf16_t*)(p.ws + WS_MIX), (const bf16_t*)(p.ws + WS_WOT), NLAT, 1024, K};
  pg8::StaticOrder S; S.init(NLAT, 1024, gridDim.x, blockIdx.x);
  EpiOut E{p.in[I_X], p.out, p.ws};
  pg8::gemm_phase<EpiOut, pg8::StaticOrder, true, true>(lds, g, S, E);
}

struct TokInfo { int bucket, pos; float wa, wb; };
__device__ __forceinline__ void phase8(const MP& p, LAS unsigned char* lds) {
  const int tid = threadIdx.x, wid = tid >> 6, lane = tid & 63; unsigned char* ws = p.ws;
  LAS float* wr = (LAS float*)lds;
  LAS int* tb = (LAS int*)(lds + 81920);
  LAS float* tw = (LAS float*)(lds + 81920 + 512);
  LAS int* base = (LAS int*)(lds + 81920 + 2048);
  for (int e = tid; e < 1024 * 20; e += NTH) { const int k = e / 20, j = e - k * 20; wr[e] = j < 4 ? p.in[I_WRG][k * 4 + j] : p.in[I_WRE][k * 16 + (j - 4)]; }
  __syncthreads();
  float* out = p.out; const float* mod = (const float*)(ws + WS_MOD); bf16_t* H = (bf16_t*)(ws + WS_H); int* cnt = (int*)(ws + WS_CNT);
  TokInfo* TI = (TokInfo*)(ws + WS_TOKINFO); const float* ST = (const float*)(ws + WS_ST1);
  for (int t0 = blockIdx.x * 128; t0 < NLAT; t0 += gridDim.x * 128) {
    const int b = t0 >> 12; const float* mb = mod + b * 6144;
    for (int i = 0; i < 16; ++i) {
      const int lt = wid * 16 + i, tok = t0 + lt;
      float s = 0.f, q = 0.f; if (lane < 16) { const f32x2 v = *(const f32x2*)(ST + ((size_t)tok * 16 + lane) * 2); s = v[0]; q = v[1]; }
#pragma unroll
      for (int o = 1; o < 16; o <<= 1) { s += __shfl_xor(s, o); q += __shfl_xor(q, o); }
      s = __shfl(s, 0); q = __shfl(q, 0);
      const float mean = s * (1.f / 1024.f), rstd = rsqrtf(fmaxf(q * (1.f / 1024.f) - mean * mean, 0.f) + EPS);
      float lg[20];
#pragma unroll
      for (int j = 0; j < 20; ++j) lg[j] = 0.f;
#pragma unroll
      for (int qd = 0; qd < 4; ++qd) { const int c = qd * 256 + lane * 4; float* zp = out + (size_t)tok * 1024 + c;
        const f32x4 z = *(const f32x4*)zp; const f32x4 g1 = *(const f32x4*)(p.in[I_LN1G] + c), b1 = *(const f32x4*)(p.in[I_LN1B] + c);
        const f32x4 x1 = (z - mean) * rstd * g1 + b1; *(f32x4*)zp = x1;
        const f32x4 sh = *(const f32x4*)(mb + 3072 + c), sc = *(const f32x4*)(mb + 4096 + c); const f32x4 hv = x1 * (1.f + sc) + sh;
        u32x2 hw; hw.x = cvt_pk(hv[0], hv[1]); hw.y = cvt_pk(hv[2], hv[3]); *(u32x2*)(H + (size_t)tok * 1024 + c) = hw;
#pragma unroll
        for (int e = 0; e < 4; ++e) { const LAS float* w = wr + (c + e) * 20;
#pragma unroll
          for (int j = 0; j < 20; ++j) lg[j] += hv[e] * w[j]; } }
#pragma unroll
      for (int j = 0; j < 20; ++j) { float v = lg[j];
#pragma unroll
        for (int o = 32; o > 0; o >>= 1) v += __shfl_xor(v, o);
        lg[j] = v; }
      if (lane == 0) {
        float gl[4]; float m = -3e38f;
#pragma unroll
        for (int j = 0; j < 4; ++j) { gl[j] = lg[j] + p.in[I_BRG][j]; m = fmaxf(m, gl[j]); }
        float ssum = 0.f;
#pragma unroll
        for (int j = 0; j < 4; ++j) { gl[j] = expf(gl[j] - m); ssum += gl[j]; }
        int gt = 0; float pg = gl[0];
#pragma unroll
        for (int j = 1; j < 4; ++j) if (gl[j] > pg) { pg = gl[j]; gt = j; }
        pg /= ssum;
        float el[4]; float em = -3e38f;
#pragma unroll
        for (int j = 0; j < 4; ++j) { const float v = gt == 0 ? lg[4 + j] : gt == 1 ? lg[8 + j] : gt == 2 ? lg[12 + j] : lg[16 + j]; el[j] = v + p.in[I_BRE][gt * 4 + j]; em = fmaxf(em, el[j]); }
        float es = 0.f;
#pragma unroll
        for (int j = 0; j < 4; ++j) { el[j] = expf(el[j] - em); es += el[j]; }
        int i1 = 0; float p1 = el[0];
#pragma unroll
        for (int j = 1; j < 4; ++j) if (el[j] > p1) { p1 = el[j]; i1 = j; }
        int i2 = -1; float p2 = -1.f;
#pragma unroll
        for (int j = 0; j < 4; ++j) if (j != i1 && el[j] > p2) { p2 = el[j]; i2 = j; }
        const float w1 = p1 / (p1 + p2) * pg, w2 = p2 / (p1 + p2) * pg;
        const int a = i1 < i2 ? i1 : i2, bb = i1 < i2 ? i2 : i1; const float wa = i1 < i2 ? w1 : w2, wb = i1 < i2 ? w2 : w1;
        const int pr = a == 0 ? bb - 1 : (a == 1 ? bb + 1 : 5);
        tb[lt] = gt * 6 + pr; tw[lt * 2] = wa; tw[lt * 2 + 1] = wb;
      }
    }
    __syncthreads();
    if (tid < 24) { int c = 0; for (int j = 0; j < 128; ++j) c += (tb[j] == tid); base[tid] = c ? atomicAdd(&cnt[tid], c) : 0; }
    __syncthreads();
    if (tid < 128) { const int bk = tb[tid]; int r = 0; for (int j = 0; j < tid; ++j) r += (tb[j] == bk);
      TokInfo ti; ti.bucket = bk; ti.pos = base[bk] + r; ti.wa = tw[tid * 2]; ti.wb = tw[tid * 2 + 1]; TI[t0 + tid] = ti; }
    __syncthreads();
  }
}

__device__ __forceinline__ void phase9(const MP& p, LAS unsigned char* lds) {
  const int tid = threadIdx.x, wid = tid >> 6, lane = tid & 63; unsigned char* ws = p.ws;
  LAS int* off = (LAS int*)lds;
  LAS int* cn = off + 32;
  int* cw = (int*)(ws + WS_CNT); int* ROWTOK = (int*)(ws + WS_ROWTOK); f32x2* ROWW = (f32x2*)(ws + WS_ROWTOK + 256 * 1024);
  if (tid == 0) { int o = 0; for (int k = 0; k < 24; ++k) { const int c = cw[k]; cn[k] = c; off[k] = o; o += ((c + 255) >> 8) << 8; } off[24] = o;
    if (blockIdx.x == 0) { cw[CW_NT] = o >> 8; int t = 0; for (int k = 0; k < 24; ++k) for (int j = 0; j < ((cn[k] + 255) >> 8); ++j) cw[CW_TB + t++] = k; } }
  __syncthreads();
  for (int k = 0; k < 24; ++k) { const int lo = off[k] + cn[k], hi = off[k + 1]; for (int r = lo + blockIdx.x * NTH + tid; r < hi; r += gridDim.x * NTH) ROWTOK[r] = -1; }
  const TokInfo* TI = (const TokInfo*)(ws + WS_TOKINFO); const bf16_t* H = (const bf16_t*)(ws + WS_H); bf16_t* HP = (bf16_t*)(ws + WS_HPERM);
  for (int tok = blockIdx.x * 8 + wid; tok < NLAT; tok += gridDim.x * 8) {
    const TokInfo ti = TI[tok]; const int row = off[ti.bucket] + ti.pos;
    if (lane == 0) { ROWTOK[row] = tok; f32x2 w = {ti.wa, ti.wb}; ROWW[row] = w; }
    const u32x4* src = (const u32x4*)(H + (size_t)tok * 1024); u32x4* dst = (u32x4*)(HP + (size_t)row * 1024);
    const u32x4 a = src[lane], b2 = src[64 + lane]; dst[lane] = a; dst[64 + lane] = b2;
  }
}

struct MoeOrder {
  int nwg, G, c; const int* tb;
  __device__ void init(const int* cw, int G_, int c_, bool w1_) { nwg = cw[CW_NT] * 4; G = G_; c = c_; tb = cw + CW_TB; w1 = w1_; }
  bool w1;
  __device__ bool next(int i, pg8::Unit& u) const { const int L = i * G + c; if (L >= nwg) return false; const int bk = tb[L >> 2], pnl = L & 3; u.pm = L >> 2; u.aux = bk * 4 + pnl;
    if (w1) { const int g = bk / 6, pr = bk - g * 6; int a, b; pair_ab(pr, a, b); u.pn = (g * 4 + ((pnl >> 1) ? b : a)) * 2 + (pnl & 1); } else u.pn = bk * 4 + pnl; return true; }
  __device__ __forceinline__ void a_ready(const pg8::Unit&) const {}
  __device__ __forceinline__ void done(const pg8::Unit&) const {}
};

struct EpiSwiglu {
  static constexpr bool PERM = true, AFTER_DRAIN = false;
  unsigned char* ws;
  __device__ __forceinline__ void operator()(const f32x4 (&acc)[2][2][4][2], const pg8::Unit& u, int wr, int wc, int fr, int fq) const {
    asm volatile("" : "+v"(fr), "+v"(fq));
    const unsigned row0 = u.pm * 256 + wr * 64 + fr; const unsigned pnl = u.aux & 3, slot = pnl >> 1, hb = pnl & 1;
    const unsigned colb = (slot * 256u + hb * 128u + wc * 32 + 8 * fq) * 2u;
#pragma unroll
    for (int ai = 0; ai < 2; ++ai)
#pragma unroll
      for (int m = 0; m < 4; ++m) {
        const unsigned row = row0 + ai * 128 + m * 16; const float w = *(const float*)(ws + (unsigned)(WS_ROWTOK + 256 * 1024 + (row * 2u + slot) * 4u));
        float he[8];
#pragma unroll
        for (int n = 0; n < 2; ++n)
#pragma unroll
          for (int e = 0; e < 4; ++e) { const float g = acc[ai][0][m][n][e], up = acc[ai][1][m][n][e]; he[n * 4 + e] = g / (1.f + __expf(-g)) * up * w; }
        u32x4 o; o.x = cvt_pk(he[0], he[1]); o.y = cvt_pk(he[2], he[3]); o.z = cvt_pk(he[4], he[5]); o.w = cvt_pk(he[6], he[7]);
        *(u32x4*)(ws + (unsigned)(WS_HE + row * 1024u + colb)) = o;
        asm volatile("" ::: "memory");
      }
  }
};
__device__ __forceinline__ void phase10(const MP& p, LAS unsigned char* lds) {
  int K = 1024; asm volatile("" : "+s"(K));
  pg8::Gemm g{(const bf16_t*)(p.ws + WS_HPERM), (const bf16_t*)(p.ws + WS_W1T), 0, 0, K};
  MoeOrder S; S.init((const int*)(p.ws + WS_CNT), gridDim.x, blockIdx.x, true);
  EpiSwiglu E{p.ws};
  pg8::gemm_phase<EpiSwiglu, MoeOrder, true, true>(lds, g, S, E);
}

struct EpiMoe {
  static constexpr bool PERM = false, AFTER_DRAIN = false;
  float* out; unsigned char* ws;
  __device__ __forceinline__ void operator()(const f32x4 (&acc)[2][2][4][2], const pg8::Unit& u, int wr, int wc, int fr, int fq) const {
    asm volatile("" : "+v"(fr), "+v"(fq));
    const unsigned row0 = u.pm * 256 + wr * 64 + fr; const unsigned pnl = u.aux & 3; const unsigned col0 = pnl * 256 + wc * 32 + 4 * fq;
#pragma unroll
    for (int ai = 0; ai < 2; ++ai)
#pragma unroll
      for (int m = 0; m < 4; ++m) {
        const unsigned row = row0 + ai * 128 + m * 16; const int tok = *(const int*)(ws + (unsigned)(WS_ROWTOK + row * 4u));
        const bool live = tok >= 0; const unsigned tk = live ? (unsigned)tok : 0u; const unsigned b = tk >> 12; const unsigned eo = tk * 1024u + col0; float s = 0.f, q = 0.f;
#pragma unroll
        for (int bj = 0; bj < 2; ++bj)
#pragma unroll
          for (int n = 0; n < 2; ++n) { const f32x4 gt = *(const f32x4*)(ws + (unsigned)(WS_MOD + (b * 6144u + 5120u + col0 + bj * 128 + n * 16) * 4u));
            const f32x4 xv = *(const f32x4*)(out + eo + bj * 128 + n * 16); const f32x4 z = xv * ALPHA + gt * acc[ai][bj][m][n];
            if (live) *(f32x4*)(out + eo + bj * 128 + n * 16) = z; s += (z[0] + z[1]) + (z[2] + z[3]); q += (z[0] * z[0] + z[1] * z[1]) + (z[2] * z[2] + z[3] * z[3]); }
        s += __shfl_xor(s, 16); s += __shfl_xor(s, 32); q += __shfl_xor(q, 16); q += __shfl_xor(q, 32);
        if (fq == 0 && live) { f32x2 st = {s, q}; *(f32x2*)(ws + (unsigned)(WS_ST2 + (tk * 16u + pnl * 4u + wc) * 8u)) = st; }
        asm volatile("" ::: "memory");
      }
  }
};
__device__ __forceinline__ void phase11(const MP& p, LAS unsigned char* lds) {
  int K = 512; asm volatile("" : "+s"(K));
  pg8::Gemm g{(const bf16_t*)(p.ws + WS_HE), (const bf16_t*)(p.ws + WS_W2T), 0, 0, K};
  MoeOrder S; S.init((const int*)(p.ws + WS_CNT), gridDim.x, blockIdx.x, false);
  EpiMoe E{p.out, p.ws};
  pg8::gemm_phase<EpiMoe, MoeOrder, true, true>(lds, g, S, E);
}

__device__ __forceinline__ void phase12(const MP& p) {
  const int tid = threadIdx.x, wid = tid >> 6, lane = tid & 63; float* out = p.out; const float* ST = (const float*)(p.ws + WS_ST2);
  for (int tok = blockIdx.x * 8 + wid; tok < NLAT; tok += gridDim.x * 8) {
    float s = 0.f, q = 0.f; if (lane < 16) { const f32x2 v = *(const f32x2*)(ST + ((size_t)tok * 16 + lane) * 2); s = v[0]; q = v[1]; }
#pragma unroll
    for (int o = 1; o < 16; o <<= 1) { s += __shfl_xor(s, o); q += __shfl_xor(q, o); }
    s = __shfl(s, 0); q = __shfl(q, 0);
    const float mean = s * (1.f / 1024.f), rstd = rsqrtf(fmaxf(q * (1.f / 1024.f) - mean * mean, 0.f) + EPS);
#pragma unroll
    for (int qd = 0; qd < 4; ++qd) { const int c = qd * 256 + lane * 4; float* zp = out + (size_t)tok * 1024 + c;
      const f32x4 z = *(const f32x4*)zp; const f32x4 g2 = *(const f32x4*)(p.in[I_LN2G] + c), b2 = *(const f32x4*)(p.in[I_LN2B] + c);
      *(f32x4*)zp = (z - mean) * rstd * g2 + b2; }
  }
}
}
namespace mk {
namespace cg = cooperative_groups;
__device__ __forceinline__ void grid_barrier(unsigned* ctr, unsigned target) {
  asm volatile("s_waitcnt vmcnt(0)" ::: "memory");
  __syncthreads();
  if (threadIdx.x == 0) {
    __builtin_amdgcn_fence(__ATOMIC_RELEASE, "agent");
    asm volatile("s_waitcnt vmcnt(0)" ::: "memory");
    __hip_atomic_fetch_add(ctr, 1u, __ATOMIC_RELAXED, __HIP_MEMORY_SCOPE_AGENT);
    unsigned spins = 0;
    while (__hip_atomic_load(ctr, __ATOMIC_RELAXED, __HIP_MEMORY_SCOPE_AGENT) < target) { __builtin_amdgcn_s_sleep(8); if (++spins > (1u << 24)) break; }
    __builtin_amdgcn_fence(__ATOMIC_ACQUIRE, "agent");
    asm volatile("s_waitcnt vmcnt(0)" ::: "memory");
  }
  __syncthreads();
}
__global__ void __launch_bounds__(NTH, 2) mega(MP p) {
  extern __shared__ __attribute__((aligned(16))) unsigned char lds_raw[];
  LAS unsigned char* lds = (LAS unsigned char*)lds_raw;
  cg::grid_group grid = cg::this_grid();
  const int lo = p.ph_lo, hi = p.ph_hi;
#define IN(k) (lo <= (k) && (k) < hi)
#define SEAM(k) do { if (IN(k) && IN((k) + 1)) { if ((k) == 0) { __threadfence(); grid.sync(); __threadfence(); } else grid_barrier(bar, (unsigned)(k) * gridDim.x); } } while (0)
  unsigned* bar = (unsigned*)(p.ws + WS_BAR);
#ifndef REP
#define REP -1
#endif
#define RPT(k, call) do { call; if ((REP) == (k)) { call; } } while (0)
  if (IN(0)) RPT(0, phase0(p, lds));
  SEAM(0);
  if (IN(1)) RPT(1, phase1(p));
  SEAM(1);
  if (IN(2)) RPT(2, phase2(p, lds));
  SEAM(2);
  if (IN(3)) RPT(3, phase3(p, lds));
  SEAM(3);
  if (IN(4)) { RPT(4, phase4_gemm(p, lds)); RPT(14, gla::stage1(p, lds)); }
  SEAM(4);
  if (IN(5)) { gla::stage2(p); RPT(5, phase5_attn(p, lds)); }
  SEAM(5);
  if (IN(6)) { RPT(6, gla::stage3(p, lds)); RPT(16, prep_expert_weights(p, lds)); }
  SEAM(6);
  if (IN(7)) RPT(7, phase7(p, lds));
  SEAM(7);
  if (IN(8)) phase8(p, lds);
  SEAM(8);
  if (IN(9)) RPT(9, phase9(p, lds));
  SEAM(9);
  if (IN(10)) RPT(10, phase10(p, lds));
  SEAM(10);
  if (IN(11)) phase11(p, lds);
  SEAM(11);
  if (IN(12)) phase12(p);
#undef IN
#undef SEAM
}
}
extern "C" void kernel_launch(void* const* d_in, const int* in_sizes, int n_in,
                              void* d_out, int out_size, void* d_ws, size_t ws_size, hipStream_t stream) {
  static int grid = 0;
  if (!grid) {
    if (hipFuncSetAttribute((const void*)mk::mega, hipFuncAttributeMaxDynamicSharedMemorySize, mk::LDS_BYTES) != hipSuccess) { fprintf(stderr, "set attr failed\n"); return; }
    int dev = 0, cus = 0, per_cu = 0;
    hipGetDevice(&dev); hipDeviceGetAttribute(&cus, hipDeviceAttributeMultiprocessorCount, dev);
    hipOccupancyMaxActiveBlocksPerMultiprocessor(&per_cu, (const void*)mk::mega, mk::NTH, mk::LDS_BYTES);
    if (per_cu < 1 || cus < 1) { fprintf(stderr, "occupancy query: %d blocks/CU, %d CUs\n", per_cu, cus); return; }
    grid = cus;
  }
  if (ws_size < mk::WS_NEED || n_in != 28 || out_size != mk::NLAT * mk::D) { fprintf(stderr, "unexpected sizes\n"); return; }
  mk::MP a{}; for (int i = 0; i < 28; ++i) a.in[i] = (const float*)d_in[i]; a.out = (float*)d_out; a.ws = (unsigned char*)d_ws;
  a.ph_lo = 0; a.ph_hi = 13; a.coop = 1; a.pad = 0;
  (void)hipMemsetAsync((char*)d_ws + mk::WS_BAR, 0, 256, stream);
  void* args[] = {&a};
  hipError_t e = hipLaunchCooperativeKernel((const void*)mk::mega, dim3(grid), dim3(mk::NTH), args, mk::LDS_BYTES, stream);
  if (e != hipSuccess) fprintf(stderr, "cooperative launch failed: %s (grid %d)\n", hipGetErrorString(e), grid);
}
```

```cpp
#define REP -1
#include <hip/hip_runtime.h>
#include <hip/hip_cooperative_groups.h>
#include <cstdio>
#include <cstdint>
#include <math.h>
namespace pg8 {
#define PG8_LAS __attribute__((address_space(3)))
typedef unsigned short bf16_t;
typedef short bf16x8 __attribute__((ext_vector_type(8)));
typedef float f32x4 __attribute__((ext_vector_type(4)));
typedef unsigned u32x4 __attribute__((ext_vector_type(4)));
constexpr int BM = 256, BK = 64, HALF = 128, HTB = HALF * BK * 2  , STAGE_BYTES = 8 * HTB, NXCD = 8, WGM = 8;

__host__ __device__ __forceinline__ int lds_byte(int r, int c) { const int st = (r >> 4) * 2 + (c >> 5), rr = r & 15, cc = c & 31, ob = rr * 64 + cc * 2; return st * 1024 + (ob ^ (((ob >> 9) & 1) << 5)); }
__host__ __device__ __forceinline__ void stage_rc(int b, int& R, int& C) { const int st = b / 1024, sb = b % 1024, swz = sb ^ (((sb >> 9) & 1) << 5); R = (st >> 1) * 16 + swz / 64; C = (st & 1) * 32 + (swz % 64) / 2; }
__host__ __device__ __forceinline__ int perm32(int rho) { const int n = rho >> 4, i = rho & 15; return 8 * (i >> 2) + 4 * n + (i & 3); }

struct Unit { int pm, pn, aux; };
struct Gemm { const bf16_t* A; const bf16_t* Bt; int M, N, K; };

struct StaticOrder {
    int nM, nN, nwg, G, c;
    __host__ __device__ void init(int M, int N, int G_, int c_) { nM = M / BM; nN = N / BM; nwg = nM * nN; G = G_; c = c_; }
    __host__ __device__ bool next(int i, Unit& u) const {
        const long L = (long)i * G + c; if (L >= nwg) return false;
        int wgid = (int)L; { const int q = nwg / NXCD, r = nwg % NXCD, xcd = wgid % NXCD, off = wgid / NXCD; wgid = (xcd < r ? xcd * (q + 1) : r * (q + 1) + (xcd - r) * q) + off; }
        const int nig = WGM * nN, gid = wgid / nig, fm = gid * WGM, gsz = (nM - fm) < WGM ? (nM - fm) : WGM;
        u.pm = fm + ((wgid % nig) % gsz); u.pn = (wgid % nig) / gsz; return true;
    }
    __device__ __forceinline__ void a_ready(const Unit&) const {}
    __device__ __forceinline__ void done(const Unit&) const {}
};

template <class Epi, class Sched, bool ALIGN_EPI = false, bool SP2 = false>
__device__ __forceinline__ void gemm_phase(PG8_LAS unsigned char* lds, const Gemm g, const Sched& S, const Epi& E) {
    const int tid = threadIdx.x, wid = __builtin_amdgcn_readfirstlane(tid >> 6), lane = tid & 63, wr = wid >> 2, wc = wid & 3, fr = lane & 15, fq = lane >> 4;
    const int K = g.K, nt = K / BK;
    unsigned voffA[2], voffB[2];
#pragma unroll
    for (int i = 0; i < 2; ++i) { int R, C; stage_rc(tid * 16 + i * 8192, R, C); const int Rb = Epi::PERM ? ((R & ~31) + perm32(R & 31)) : R;
        voffA[i] = (unsigned)(R * K + C) * 2u; voffB[i] = (unsigned)(Rb * K + C) * 2u; }
    const size_t kstep = (size_t)(BK * 2);
    const size_t hstep = (size_t)HALF * K * 2;
    const size_t tstep = 2 * hstep;
    const unsigned ldsw = (unsigned)wid * 1024u;
    const int aoff = lds_byte(wr * 64 + fr, fq * 8), boff = lds_byte(wc * 32 + fr, fq * 8);
#define PG8_SA(b, h) (((b) * 2 + (h)) * HTB)
#define PG8_SB(b, h) ((4 + (b) * 2 + (h)) * HTB)
#define PG8_STAGE(bufoff, gbase, voff) do { _Pragma("unroll") for (int _i = 0; _i < 2; ++_i) \
        __builtin_amdgcn_global_load_lds((const unsigned*)((const char*)(gbase) + (voff)[_i]), (PG8_LAS unsigned*)(lds + (bufoff) + ldsw + _i * 8192), 16, 0, 0); } while (0)
#define PG8_LDA(dst, b, h) do { _Pragma("unroll") for (int m = 0; m < 4; ++m) _Pragma("unroll") for (int k = 0; k < 2; ++k) dst[m][k] = *(const PG8_LAS bf16x8*)(lds + PG8_SA(b, h) + aoff + m * 2048 + k * 1024); } while (0)
#define PG8_LDB(dst, b, h) do { _Pragma("unroll") for (int n = 0; n < 2; ++n) _Pragma("unroll") for (int k = 0; k < 2; ++k) dst[n][k] = *(const PG8_LAS bf16x8*)(lds + PG8_SB(b, h) + boff + n * 2048 + k * 1024); } while (0)
#define PG8_MMA(ai, bj, At, Bt) do { __builtin_amdgcn_s_setprio(1); _Pragma("unroll") for (int m = 0; m < 4; ++m) _Pragma("unroll") for (int n = 0; n < 2; ++n) _Pragma("unroll") for (int k = 0; k < 2; ++k) \
        acc[ai][bj][m][n] = __builtin_amdgcn_mfma_f32_16x16x32_bf16(Bt[n][k], At[m][k], acc[ai][bj][m][n], 0, 0, 0); __builtin_amdgcn_s_setprio(0); } while (0)
#define PG8_WAIT_V(n) asm volatile("s_waitcnt vmcnt(" #n ")" ::: "memory")
#define PG8_WAIT_L(n) asm volatile("s_waitcnt lgkmcnt(" #n ")" ::: "memory")
#define PG8_BAR __builtin_amdgcn_s_barrier()
#define PG8_SCHED __builtin_amdgcn_sched_barrier(0)
    Unit cur, nxt; int ui = 0;
    if (!S.next(0, cur)) return;
    f32x4 acc[2][2][4][2];
#pragma unroll
    for (int a = 0; a < 2; ++a)
#pragma unroll
        for (int b = 0; b < 2; ++b)
#pragma unroll
            for (int m = 0; m < 4; ++m)
#pragma unroll
                for (int n = 0; n < 2; ++n) acc[a][b][m][n] = (f32x4){0.f, 0.f, 0.f, 0.f};
    bf16x8 At[4][2], B0[2][2], B1[2][2];
    const char* cA = (const char*)g.A + (size_t)cur.pm * tstep; const char* cB = (const char*)g.Bt + (size_t)cur.pn * tstep;
    S.a_ready(cur);
    if constexpr (SP2) {
        PG8_STAGE(PG8_SB(0, 0), cB, voffB); PG8_STAGE(PG8_SB(0, 1), cB + hstep, voffB); PG8_STAGE(PG8_SA(0, 0), cA, voffA); PG8_STAGE(PG8_SA(0, 1), cA + hstep, voffA);
        if (wr == 1) PG8_BAR;
        PG8_WAIT_V(2); PG8_BAR;
        PG8_STAGE(PG8_SB(1, 0), cB + kstep, voffB); PG8_STAGE(PG8_SA(1, 0), cA + kstep, voffA); PG8_STAGE(PG8_SB(1, 1), cB + hstep + kstep, voffB);
        PG8_WAIT_V(6); PG8_BAR;
    } else {
        PG8_STAGE(PG8_SB(0, 0), cB, voffB); PG8_STAGE(PG8_SA(0, 0), cA, voffA); PG8_STAGE(PG8_SB(0, 1), cB + hstep, voffB); PG8_STAGE(PG8_SA(0, 1), cA + hstep, voffA);
        if (wr == 1) PG8_BAR;
        PG8_WAIT_V(4); PG8_BAR;
        PG8_STAGE(PG8_SB(1, 0), cB + kstep, voffB); PG8_STAGE(PG8_SA(1, 0), cA + kstep, voffA); PG8_STAGE(PG8_SB(1, 1), cB + hstep + kstep, voffB);
        PG8_WAIT_V(6); PG8_BAR;
    }
    for (;;) {
        const bool has_next = S.next(ui + 1, nxt);
        const char* nA = has_next ? (const char*)g.A + (size_t)nxt.pm * tstep : cA; const char* nB = has_next ? (const char*)g.Bt + (size_t)nxt.pn * tstep : cB;
        for (int t = 0; t < nt; t += 2) {
            const bool last = (t == nt - 2);
            const char* a1 = cA + (size_t)(t + 1) * kstep;
            const char* a2 = last ? nA : cA + (size_t)(t + 2) * kstep; const char* b2 = last ? nB : cB + (size_t)(t + 2) * kstep;
            const char* a3 = a2 + kstep; const char* b3 = b2 + kstep;
            if (last && has_next) S.a_ready(nxt);
            if constexpr (SP2) {
            PG8_LDB(B0, 0, 0); PG8_LDB(B1, 0, 1); PG8_SCHED; PG8_LDA(At, 0, 0); PG8_STAGE(PG8_SA(1, 1), a1 + hstep, voffA);
            PG8_WAIT_V(8); PG8_WAIT_L(0); PG8_BAR; PG8_MMA(0, 0, At, B0); PG8_MMA(0, 1, At, B1); PG8_BAR; PG8_SCHED;
            PG8_LDA(At, 0, 1); PG8_STAGE(PG8_SB(0, 0), b2, voffB); PG8_STAGE(PG8_SB(0, 1), b2 + hstep, voffB); PG8_STAGE(PG8_SA(0, 0), a2, voffA);
            PG8_WAIT_V(8); PG8_WAIT_L(0); PG8_BAR; PG8_MMA(1, 0, At, B0); PG8_MMA(1, 1, At, B1); PG8_BAR; PG8_SCHED;
            PG8_LDB(B0, 1, 0); PG8_LDB(B1, 1, 1); PG8_SCHED; PG8_LDA(At, 1, 0); PG8_STAGE(PG8_SA(0, 1), a2 + hstep, voffA);
            PG8_WAIT_V(8); PG8_WAIT_L(0); PG8_BAR; PG8_MMA(0, 0, At, B0); PG8_MMA(0, 1, At, B1); PG8_BAR; PG8_SCHED;
            PG8_LDA(At, 1, 1); PG8_STAGE(PG8_SB(1, 0), b3, voffB); PG8_STAGE(PG8_SB(1, 1), b3 + hstep, voffB); PG8_STAGE(PG8_SA(1, 0), a3, voffA);
            PG8_WAIT_V(8); PG8_WAIT_L(0); PG8_BAR; PG8_MMA(1, 0, At, B0); PG8_MMA(1, 1, At, B1); PG8_BAR; PG8_SCHED;
            } else {
            PG8_LDB(B0, 0, 0); PG8_SCHED; PG8_LDA(At, 0, 0); PG8_STAGE(PG8_SA(1, 1), a1 + hstep, voffA);
            PG8_WAIT_L(8); PG8_BAR; PG8_WAIT_L(0); PG8_MMA(0, 0, At, B0); PG8_BAR; PG8_SCHED;
            PG8_LDB(B1, 0, 1); PG8_STAGE(PG8_SB(0, 0), b2, voffB);
            PG8_BAR; PG8_WAIT_L(0); PG8_MMA(0, 1, At, B1); PG8_BAR;
            PG8_LDA(At, 0, 1); PG8_STAGE(PG8_SA(0, 0), a2, voffA);
            PG8_BAR; PG8_WAIT_L(0); PG8_MMA(1, 0, At, B0); PG8_BAR; PG8_SCHED;
            PG8_STAGE(PG8_SB(0, 1), b2 + hstep, voffB);
            PG8_WAIT_V(6); PG8_BAR; PG8_MMA(1, 1, At, B1); PG8_BAR;
            PG8_LDB(B0, 1, 0); PG8_SCHED; PG8_LDA(At, 1, 0); PG8_STAGE(PG8_SA(0, 1), a2 + hstep, voffA);
            PG8_WAIT_L(8); PG8_BAR; PG8_WAIT_L(0); PG8_MMA(0, 0, At, B0); PG8_BAR; PG8_SCHED;
            PG8_LDB(B1, 1, 1); PG8_STAGE(PG8_SB(1, 0), b3, voffB);
            PG8_BAR; PG8_WAIT_L(0); PG8_MMA(0, 1, At, B1); PG8_BAR;
            PG8_LDA(At, 1, 1); PG8_STAGE(PG8_SA(1, 0), a3, voffA);
            PG8_BAR; PG8_WAIT_L(0); PG8_MMA(1, 0, At, B0); PG8_BAR; PG8_SCHED;
            PG8_STAGE(PG8_SB(1, 1), b3 + hstep, voffB);
            PG8_WAIT_V(6); PG8_BAR; PG8_MMA(1, 1, At, B1); PG8_BAR;
            }
        }
        if constexpr (ALIGN_EPI) { if (wr == 0) PG8_BAR; }
        if constexpr (!Epi::AFTER_DRAIN) { E(acc, cur, wr, wc, fr, fq); S.done(cur); }
        if (!has_next) break;
#pragma unroll
        for (int a = 0; a < 2; ++a)
#pragma unroll
            for (int b = 0; b < 2; ++b)
#pragma unroll
                for (int m = 0; m < 4; ++m)
#pragma unroll
                    for (int n = 0; n < 2; ++n) acc[a][b][m][n] = (f32x4){0.f, 0.f, 0.f, 0.f};
        cur = nxt; cA = nA; cB = nB; ++ui;
        if constexpr (ALIGN_EPI) { if (wr == 1) PG8_BAR; }
    }
    PG8_WAIT_V(0);
    if constexpr (!ALIGN_EPI) { if (wr == 0) PG8_BAR; }
    PG8_BAR;
    if constexpr (Epi::AFTER_DRAIN) { E.fused(acc, cur, wr, wc, fr, fq, lds, wid, lane); S.done(cur); }
#undef PG8_SA
#undef PG8_SB
#undef PG8_STAGE
#undef PG8_LDA
#undef PG8_LDB
#undef PG8_MMA
#undef PG8_WAIT_V
#undef PG8_WAIT_L
#undef PG8_BAR
#undef PG8_SCHED
}
}
namespace mk {
using pg8::bf16_t; using pg8::bf16x8; using pg8::f32x4; using pg8::u32x4;
typedef float f32x8 __attribute__((ext_vector_type(8)));
typedef float f32x16 __attribute__((ext_vector_type(16)));
typedef float f32x2 __attribute__((ext_vector_type(2)));
typedef unsigned u32x2 __attribute__((ext_vector_type(2)));
#define LAS __attribute__((address_space(3)))

constexpr int NTH = 512;
constexpr int D = 1024, NB = 8, SEQ = 4096, CTXL = 256;
constexpr int NLAT = NB * SEQ;
constexpr int NCTX = NB * CTXL;
constexpr int MROWS = NLAT + NCTX;
constexpr float ALPHA = 1.189207115002721f;
constexpr float EPS = 1e-6f;
constexpr float QSCALE = 0.10206207261596575f * 1.4426950408889634f;

constexpr size_t MiB = 1u << 20;
constexpr size_t WS_MOD = 0;
constexpr size_t WS_ROPE = 1 * MiB;
constexpr size_t WS_RS = 2 * MiB;
constexpr size_t WS_CNT = 3 * MiB;
constexpr size_t WS_TOKINFO = 4 * MiB;
constexpr size_t WS_ROWTOK = 5 * MiB;
constexpr size_t WS_BAR = 3 * MiB + 65536;
constexpr size_t WS_ST1 = 6 * MiB;
constexpr size_t WS_ST2 = 10 * MiB;
constexpr size_t WS_WINT = 16 * MiB, WS_WOT = 20 * MiB, WS_WUPT = 22 * MiB;
constexpr size_t WS_U = 24 * MiB;
constexpr size_t WS_MIX = WS_U;
constexpr size_t WS_QG = 92 * MiB, WS_KG = 109 * MiB, WS_VG = 126 * MiB, WS_RG = 160 * MiB;
constexpr size_t WS_A2 = 194 * MiB;
constexpr size_t WS_KR = WS_A2 + 26738688;
constexpr size_t WS_GFB = WS_KR + 4456448;
constexpr size_t WS_LGF = 228 * MiB, WS_LGB = 262 * MiB;
constexpr size_t WS_QC = 296 * MiB, WS_KC = 344 * MiB, WS_VC = 395 * MiB;
constexpr size_t WS_DS = 429 * MiB;
constexpr size_t WS_END = 497 * MiB;
constexpr size_t WS_W1T = 296 * MiB, WS_W2T = 344 * MiB;
constexpr size_t WS_H = 92 * MiB;
constexpr size_t WS_HPERM = 156 * MiB;
constexpr size_t WS_HE = 232 * MiB;
constexpr size_t WS_NEED = 497 * MiB;

constexpr int LDS_BYTES = 140 * 1024;

struct MP { const float* in[28]; float* out; unsigned char* ws; int ph_lo, ph_hi, coop, pad; };
enum { I_X = 0, I_C, I_CTX, I_CCTX, I_WADA, I_BADA, I_WIN, I_WGKF, I_BGKF, I_WGKB, I_BGKB, I_GLAG, I_QNG, I_WUQ, I_KVNG, I_WUKV, I_WO, I_LN1G, I_LN1B,
       I_WRG, I_BRG, I_WRE, I_BRE, I_WEG, I_WEU, I_WED, I_LN2G, I_LN2B };

typedef __bf16 bf16x2_t __attribute__((ext_vector_type(2)));
__device__ __forceinline__ unsigned cvt_pk(float lo, float hi) { f32x2 v = {lo, hi}; bf16x2_t b = __builtin_convertvector(v, bf16x2_t); return __builtin_bit_cast(unsigned, b); }
__device__ __forceinline__ float bf2f(unsigned short h) { return __uint_as_float(((unsigned)h) << 16); }
__device__ __forceinline__ float bflo(unsigned w) { return __uint_as_float(w << 16); }
__device__ __forceinline__ float bfhi(unsigned w) { return __uint_as_float(w & 0xffff0000u); }
__device__ __forceinline__ float silu_f(float x) { return x / (1.f + __expf(-x)); }

__device__ __forceinline__ int grow(int b, int r) { return r < SEQ ? b * SEQ + r : NLAT + b * CTXL + (r - SEQ); }

__host__ __device__ __forceinline__ int rope_unperm(int jp) { const int half = jp >> 4, i = (jp >> 1) & 7, sec = jp & 1; return half * 16 + sec * 8 + i; }

struct SrcWin {
  const float* w;
  __device__ __forceinline__ float operator()(int n, int k) const {
    int src;
    if (n < 1024) src = n;
    else if (n < 1536) src = 1056 + (n - 1024);
    else if (n < 1792) src = 1568 + (n - 1536);
    else { const int c = n - 1792;
      if (c < 128) src = 1824 + c;
      else if (c < 160) src = 1952 + rope_unperm(c - 128);
      else if (c < 176) src = 1024 + (c - 160);
      else if (c < 192) src = 1040 + (c - 176);
      else return 0.f; }
    return w[(size_t)k * 1984 + src];
  }
};
struct SrcWup {
  const float *wq, *gq, *wkv, *gkv;
  __device__ __forceinline__ float operator()(int n, int k) const {
    if (n < 768) { if (k >= 256) return 0.f; const int h = n / 96, dp = n % 96; const int d = dp < 64 ? dp : 64 + rope_unperm(dp - 64);
      return wq[(size_t)k * 768 + h * 96 + d] * gq[k]; }
    if (k < 256) return 0.f;
    return wkv[(size_t)(k - 256) * 1024 + (n - 768)] * gkv[k - 256];
  }
};
struct SrcWo { const float* w; __device__ __forceinline__ float operator()(int n, int k) const { return w[(size_t)k * 1024 + n]; } };
__host__ __device__ __forceinline__ void pair_ab(int p, int& a, int& b) { a = p < 3 ? 0 : (p < 5 ? 1 : 2); b = p < 3 ? p + 1 : (p < 5 ? p - 1 : 3); }
struct SrcW1 {
  const float *wg, *wu;
  __device__ __forceinline__ float operator()(int n, int k) const {
    const int e = n >> 9, r = n & 511, hb = r >> 8, rr = r & 255, hid = hb * 128 + (rr & 127);
    const long delta = (rr < 128) ? 0L : (long)(wu - wg);
    return wg[(long)(((size_t)e * 1024 + k) * 256 + hid) + delta];
  }
};
struct SrcW2 {
  const float* wd;
  __device__ __forceinline__ float operator()(int n, int k) const {
    const int bk = n >> 10, col = n & 1023, g = bk / 6, p = bk % 6; int a, b; pair_ab(p, a, b);
    const int e = g * 4 + ((k >> 8) ? b : a);
    return wd[((size_t)e * 256 + (k & 255)) * 1024 + col];
  }
};
template <class Src> __device__ __forceinline__ void wprep_tile(const Src& S, bf16_t* Wt, int K, int n0, int k0, LAS float* t) {
  const int tid = threadIdx.x;
  { const int nl = tid & 63, kk0 = tid >> 6;
#pragma unroll
    for (int i = 0; i < 16; ++i) { const int kk = kk0 + 8 * i; t[kk * 65 + nl] = S(n0 + nl, k0 + kk); } }
  __syncthreads();
  { const int nl = tid >> 3, ks = (tid & 7) * 16; u32x4 w, w2;
    w.x = cvt_pk(t[(ks + 0) * 65 + nl], t[(ks + 1) * 65 + nl]); w.y = cvt_pk(t[(ks + 2) * 65 + nl], t[(ks + 3) * 65 + nl]);
    w.z = cvt_pk(t[(ks + 4) * 65 + nl], t[(ks + 5) * 65 + nl]); w.w = cvt_pk(t[(ks + 6) * 65 + nl], t[(ks + 7) * 65 + nl]);
    w2.x = cvt_pk(t[(ks + 8) * 65 + nl], t[(ks + 9) * 65 + nl]); w2.y = cvt_pk(t[(ks + 10) * 65 + nl], t[(ks + 11) * 65 + nl]);
    w2.z = cvt_pk(t[(ks + 12) * 65 + nl], t[(ks + 13) * 65 + nl]); w2.w = cvt_pk(t[(ks + 14) * 65 + nl], t[(ks + 15) * 65 + nl]);
    bf16_t* d = Wt + (size_t)(n0 + nl) * K + k0 + ks; *(u32x4*)d = w; *(u32x4*)(d + 8) = w2; }
  __syncthreads();
}
template <class Src> __device__ __forceinline__ void wprep(const Src& S, bf16_t* Wt, int N, int K, LAS float* t, int& cursor) {
  const int tk = K / 128, tiles = (N / 64) * tk, G = gridDim.x;
  int first = ((int)blockIdx.x - cursor) % G; if (first < 0) first += G;
  for (int i = first; i < tiles; i += G) wprep_tile(S, Wt, K, (i / tk) * 64, (i % tk) * 128, t);
  cursor += tiles;
}

__device__ __forceinline__ void phase0(const MP& p, LAS unsigned char* lds) {
  const int tid = threadIdx.x, bid = blockIdx.x, G = gridDim.x;
  unsigned char* ws = p.ws;
  if (bid == 0) { int* cnt = (int*)(ws + WS_CNT); for (int i = tid; i < 4096; i += NTH) cnt[i] = 0; }
  { float* rope = (float*)(ws + WS_ROPE);
    for (int e = bid * NTH + tid; e < 4096 * 16; e += G * NTH) { const int s = e >> 4, a = e & 15, half = a >> 3, i = a & 7;
      const float pos = half ? (float)(s & 63) : (float)(s >> 6); const float inv = powf(10000.f, -(float)i / 8.f); const float ang = pos * inv;
      rope[e * 2] = cosf(ang); rope[e * 2 + 1] = sinf(ang); } }
  { LAS float* sc = (LAS float*)lds;
    LAS float* red = sc + 9 * 1024;
    const bool have = bid < 192;
    if (have) {
      for (int e = tid; e < 9 * 1024; e += NTH) { const int r = e >> 10, k = e & 1023; const float x = r < 8 ? p.in[I_C][r * 1024 + k] : p.in[I_CCTX][k]; sc[e] = x / (1.f + expf(-x)); }
      __syncthreads();
      for (int it = bid; it < 192; it += G) {
        const int col = it * 32 + (tid & 31), kg = tid >> 5; float acc[9];
#pragma unroll
        for (int r = 0; r < 9; ++r) acc[r] = 0.f;
        const float* w = p.in[I_WADA] + (size_t)(kg * 64) * 6144 + col;
#pragma unroll 8
        for (int k = 0; k < 64; ++k) { const float wv = w[(size_t)k * 6144];
#pragma unroll
          for (int r = 0; r < 9; ++r) acc[r] += sc[r * 1024 + kg * 64 + k] * wv; }
#pragma unroll
        for (int r = 0; r < 9; ++r) red[(kg * 9 + r) * 32 + (tid & 31)] = acc[r];
        __syncthreads();
        for (int e = tid; e < 9 * 32; e += NTH) { const int r = e >> 5, c = e & 31; float s = 0.f;
#pragma unroll
          for (int g = 0; g < 16; ++g) s += red[(g * 9 + r) * 32 + c];
          ((float*)(ws + WS_MOD))[r * 6144 + it * 32 + c] = s + p.in[I_BADA][it * 32 + c]; }
        __syncthreads();
      }
    }
    __syncthreads();
  }
  { LAS float* t = (LAS float*)lds; int cursor = 192;
    wprep(SrcWin{p.in[I_WIN]}, (bf16_t*)(ws + WS_WINT), 2048, 1024, t, cursor);
    wprep(SrcWup{p.in[I_WUQ], p.in[I_QNG], p.in[I_WUKV], p.in[I_KVNG]}, (bf16_t*)(ws + WS_WUPT), 1792, 384, t, cursor);
    wprep(SrcWo{p.in[I_WO]}, (bf16_t*)(ws + WS_WOT), 1024, 1024, t, cursor); }
}

__device__ __forceinline__ void phase1(const MP& p) {
  const float* mod = (const float*)(p.ws + WS_MOD); bf16_t* U = (bf16_t*)(p.ws + WS_U);
  const int total = MROWS * 128;
  for (int e = blockIdx.x * NTH + threadIdx.x; e < total; e += gridDim.x * NTH) {
    const int row = e >> 7, c8 = (e & 127) * 8;
    const float* src; const float* m;
    if (row < NLAT) { src = p.in[I_X] + (size_t)row * D; m = mod + (row >> 12) * 6144; } else { src = p.in[I_CTX] + (size_t)(row - NLAT) * D; m = mod + 8 * 6144; }
    const f32x4 x0 = *(const f32x4*)(src + c8), x1 = *(const f32x4*)(src + c8 + 4);
    const f32x4 s0 = *(const f32x4*)(m + c8), s1 = *(const f32x4*)(m + c8 + 4), g0 = *(const f32x4*)(m + 1024 + c8), g1 = *(const f32x4*)(m + 1024 + c8 + 4);
    const f32x4 u0 = x0 * (1.f + g0) + s0, u1 = x1 * (1.f + g1) + s1;
    u32x4 w; w.x = cvt_pk(u0[0], u0[1]); w.y = cvt_pk(u0[2], u0[3]); w.z = cvt_pk(u1[0], u1[1]); w.w = cvt_pk(u1[2], u1[3]);
    *(u32x4*)(U + (size_t)row * D + c8) = w;
  }
}

struct EpiIn {
  static constexpr bool PERM = true, AFTER_DRAIN = false;
  unsigned char* ws;
  __device__ __forceinline__ void operator()(const f32x4 (&acc)[2][2][4][2], const pg8::Unit& u, int wr, int wc, int fr, int fq) const {
    asm volatile("" : "+v"(fr), "+v"(fq));
    const int row0 = u.pm * 256 + wr * 64 + fr; const int pn = u.pn;
#pragma unroll
    for (int bj = 0; bj < 2; ++bj) {
      const int cl = bj * 128 + wc * 32 + 8 * fq;
      bf16_t* base = nullptr; int ld = 0; float* fbase = nullptr; bool skip = false;
      if (pn == 0) { base = (bf16_t*)(ws + WS_QG) + cl; ld = 256; }
      else if (pn == 1) { base = (bf16_t*)(ws + WS_KG) + cl; ld = 256; }
      else if (pn < 4) { base = (bf16_t*)(ws + WS_VG) + (pn - 2) * 256 + cl; ld = 512; }
      else if (pn < 6) { base = (bf16_t*)(ws + WS_RG) + (pn - 4) * 256 + cl; ld = 512; }
      else if (pn == 6) { base = (bf16_t*)(ws + WS_A2) + cl; ld = 384; }
      else { if (cl < 128) { base = (bf16_t*)(ws + WS_A2) + 256 + cl; ld = 384; }
             else if (cl < 160) fbase = (float*)(ws + WS_KR) + (cl - 128);
             else if (cl < 192) fbase = (float*)(ws + WS_GFB) + (cl - 160);
             else skip = true; }
      if (skip) continue;
#pragma unroll
      for (int ai = 0; ai < 2; ++ai)
#pragma unroll
        for (int m = 0; m < 4; ++m) { const int row = row0 + ai * 128 + m * 16; const f32x4 v0 = acc[ai][bj][m][0], v1 = acc[ai][bj][m][1];
          if (base) { u32x4 w; w.x = cvt_pk(v0[0], v0[1]); w.y = cvt_pk(v0[2], v0[3]); w.z = cvt_pk(v1[0], v1[1]); w.w = cvt_pk(v1[2], v1[3]);
            *(u32x4*)(base + (size_t)row * ld) = w; }
          else { *(f32x4*)(fbase + (size_t)row * 32) = v0; *(f32x4*)(fbase + (size_t)row * 32 + 4) = v1; } }
    }
  }
};
__device__ __forceinline__ void phase2(const MP& p, LAS unsigned char* lds) {
  pg8::Gemm g{(const bf16_t*)(p.ws + WS_U), (const bf16_t*)(p.ws + WS_WINT), MROWS, 2048, 1024};
  pg8::StaticOrder S; S.init(MROWS, 2048, gridDim.x, blockIdx.x);
  EpiIn E{p.ws};
  pg8::gemm_phase<EpiIn, pg8::StaticOrder, true, true>(lds, g, S, E);
}

__global__ void bridge1_k(const unsigned char* ws, float* pn, int b) {
  const int r = blockIdx.x; const int gr = grow(b, r);
  const bf16_t* QG = (const bf16_t*)(ws + WS_QG); const bf16_t* KG = (const bf16_t*)(ws + WS_KG); const bf16_t* VG = (const bf16_t*)(ws + WS_VG);
  const bf16_t* RG = (const bf16_t*)(ws + WS_RG); const bf16_t* A2 = (const bf16_t*)(ws + WS_A2); const float* KR = (const float*)(ws + WS_KR); const float* GFB = (const float*)(ws + WS_GFB);
  for (int c = threadIdx.x; c < 1984; c += 256) { float v;
    if (c < 256) v = bf2f(QG[(size_t)gr * 256 + c]);
    else if (c < 512) v = bf2f(KG[(size_t)gr * 256 + c - 256]);
    else if (c < 1024) v = bf2f(VG[(size_t)gr * 512 + c - 512]);
    else if (c < 1056) v = GFB[(size_t)gr * 32 + c - 1024];
    else if (c < 1568) v = bf2f(RG[(size_t)gr * 512 + c - 1056]);
    else if (c < 1824) v = bf2f(A2[(size_t)gr * 384 + c - 1568]);
    else if (c < 1952) v = bf2f(A2[(size_t)gr * 384 + 256 + c - 1824]);
    else { const int j = c - 1952; int jp = 0; for (int q = 0; q < 32; ++q) if (rope_unperm(q) == j) jp = q; v = KR[(size_t)gr * 32 + jp]; }
    pn[(size_t)r * 1984 + c] = v; }
}
}
namespace mk {
#define XB_TMO      128
#define XB_XCNT(j)  (256  + 64 * (j))
#define XB_XSUB(j)  (1280 + 64 * (j))
#define XB_XGEN(j)  (2304 + 64 * (j))
#define XB_TOP      3328
#define XB_TOPGEN   3392
#define XCD_BAR_WORDS 3456
#define XB_SPIN_CAP (1u << 18)

__device__ __forceinline__ unsigned xb_ld(unsigned* p)              { return __hip_atomic_load(p, __ATOMIC_RELAXED, __HIP_MEMORY_SCOPE_AGENT); }
__device__ __forceinline__ unsigned xb_add(unsigned* p, unsigned v) { return __hip_atomic_fetch_add(p, v, __ATOMIC_RELAXED, __HIP_MEMORY_SCOPE_AGENT); }
__device__ __forceinline__ unsigned xb_xcc_id() { return (unsigned)__builtin_amdgcn_s_getreg((3 << 11) | 20) & 0xFu; }
#define XB_SPIN(cond, bar) do { unsigned _sp = 0; while (cond) { __builtin_amdgcn_s_sleep(1); \
    if ((++_sp & 255u) == 0u) { if (xb_ld(&(bar)[XB_TMO])) break; if (_sp > XB_SPIN_CAP) { atomicAdd(&(bar)[XB_TMO], 1u); break; } } } } while (0)

struct XcdBarrier {
    unsigned* bar; unsigned x;
    volatile LAS unsigned* st;
};

__device__ __forceinline__ XcdBarrier xcd_barrier_post(unsigned* bar, volatile LAS unsigned* st) {
    XcdBarrier b; b.bar = bar; b.x = xb_xcc_id(); b.st = st;
    if (threadIdx.x == 0) (void)xb_add(&bar[XB_XCNT(b.x)], 1u);
    return b;
}
__device__ __forceinline__ void xcd_barrier_complete(unsigned* bar, unsigned x, unsigned& nloc, unsigned& nx) {
    const unsigned G = gridDim.x * gridDim.y * gridDim.z;
    unsigned sum, cnt, mine, sp = 0u;
    for (;;) {
        sum = 0u; cnt = 0u; mine = 0u;
#pragma unroll
        for (unsigned j = 0; j < 16; ++j) { const unsigned c = xb_ld(&bar[XB_XCNT(j)]); sum += c; cnt += (c > 0u) ? 1u : 0u; mine = (j == x) ? c : mine; }
        if (sum == G) break;
        __builtin_amdgcn_s_sleep(1);
        if ((++sp & 255u) == 0u) { if (xb_ld(&bar[XB_TMO])) break; if (sp > XB_SPIN_CAP) { atomicAdd(&bar[XB_TMO], 1u); break; } }
    }
    nloc = mine > 0u ? mine : 1u; nx = cnt > 0u ? cnt : 1u;
}

__device__ __forceinline__ void xcd_barrier(const XcdBarrier& b) {
    asm volatile("s_waitcnt vmcnt(0)" ::: "memory");
    __syncthreads();
    if (threadIdx.x == 0) {
        unsigned* bar = b.bar;
        __builtin_amdgcn_s_waitcnt(0);
        unsigned nloc = b.st[0], nx = b.st[1];
        if (nloc == 0u) { xcd_barrier_complete(bar, b.x, nloc, nx); b.st[0] = nloc; b.st[1] = nx; }
        const unsigned old = xb_add(&bar[XB_XSUB(b.x)], 1u);
        const unsigned gen = old / nloc;
        if (old + 1u == (gen + 1u) * nloc) {
            __builtin_amdgcn_fence(__ATOMIC_RELEASE, "agent");
            asm volatile("s_waitcnt vmcnt(0)" ::: "memory");
            const unsigned og = xb_add(&bar[XB_TOP], 1u);
            const unsigned tg = og / nx;
            if (og + 1u == (tg + 1u) * nx) xb_add(&bar[XB_TOPGEN], 1u);
            else XB_SPIN(xb_ld(&bar[XB_TOPGEN]) == tg, bar);
            __builtin_amdgcn_fence(__ATOMIC_ACQUIRE, "agent");
            xb_add(&bar[XB_XGEN(b.x)], 1u);
            asm volatile("s_waitcnt vmcnt(0)" ::: "memory");
        } else {
            XB_SPIN(xb_ld(&bar[XB_XGEN(b.x)]) == gen, bar);
            __builtin_amdgcn_fence(__ATOMIC_ACQUIRE, "agent");
            asm volatile("s_waitcnt vmcnt(0)" ::: "memory");
        }
    }
    __syncthreads();
}

}
namespace mk {
__device__ __forceinline__ float logsig_f(float x) { return fminf(x, 0.f) - __logf(1.f + __expf(-fabsf(x))); }
__device__ __forceinline__ int chunk_row0(int u) { return u < 512 ? u * 64 : NLAT + (u - 512) * 64; }

__device__ __forceinline__ void phase3(const MP& p, LAS unsigned char* lds) {
  const int tid = threadIdx.x; unsigned char* ws = p.ws;
  const bf16_t* A2 = (const bf16_t*)(ws + WS_A2); const float* KR = (const float*)(ws + WS_KR); const float* GFB = (const float*)(ws + WS_GFB);
  float* RS = (float*)(ws + WS_RS); const float* rope = (const float*)(ws + WS_ROPE); bf16_t* KC = (bf16_t*)(ws + WS_KC);
  float* LGF = (float*)(ws + WS_LGF); float* LGB = (float*)(ws + WS_LGB);
  LAS float* gl = (LAS float*)lds;
  const int gcol = tid & 255, gdir = tid >> 8;
  float gw[16];
  { const float* W = gdir ? p.in[I_WGKB] : p.in[I_WGKF];
#pragma unroll
    for (int i = 0; i < 16; ++i) gw[i] = W[i * 256 + gcol]; }
  const float gbias = (gdir ? p.in[I_BGKB] : p.in[I_BGKF])[gcol];
  for (int u = blockIdx.x; u < 544; u += gridDim.x) {
    const int r0 = chunk_row0(u); const bool lat = u < 512;
    { const int row = tid >> 3, c4 = (tid & 7) * 4; *(LAS f32x4*)(gl + row * 32 + c4) = *(const f32x4*)(GFB + (size_t)(r0 + row) * 32 + c4); }
    { const int row = tid >> 3, seg = tid & 7; const bf16_t* ar = A2 + (size_t)(r0 + row) * 384; float sq = 0.f, skv = 0.f;
#pragma unroll
      for (int i = 0; i < 4; ++i) { const u32x4 w = *(const u32x4*)(ar + seg * 32 + i * 8);
        sq += bflo(w.x) * bflo(w.x) + bfhi(w.x) * bfhi(w.x) + bflo(w.y) * bflo(w.y) + bfhi(w.y) * bfhi(w.y) + bflo(w.z) * bflo(w.z) + bfhi(w.z) * bfhi(w.z) + bflo(w.w) * bflo(w.w) + bfhi(w.w) * bfhi(w.w); }
#pragma unroll
      for (int i = 0; i < 2; ++i) { const u32x4 w = *(const u32x4*)(ar + 256 + seg * 16 + i * 8);
        skv += bflo(w.x) * bflo(w.x) + bfhi(w.x) * bfhi(w.x) + bflo(w.y) * bflo(w.y) + bfhi(w.y) * bfhi(w.y) + bflo(w.z) * bflo(w.z) + bfhi(w.z) * bfhi(w.z) + bflo(w.w) * bflo(w.w) + bfhi(w.w) * bfhi(w.w); }
      sq += __shfl_xor(sq, 1); sq += __shfl_xor(sq, 2); sq += __shfl_xor(sq, 4);
      skv += __shfl_xor(skv, 1); skv += __shfl_xor(skv, 2); skv += __shfl_xor(skv, 4);
      if (seg == 0) { RS[(size_t)(r0 + row) * 2] = rsqrtf(sq * (1.f / 256.f) + EPS); RS[(size_t)(r0 + row) * 2 + 1] = rsqrtf(skv * (1.f / 128.f) + EPS); } }
    { const int row = tid >> 3, h = tid & 7; const int gr = r0 + row; const float* kr = KR + (size_t)gr * 32; const float* rp = rope + (size_t)(gr & 4095) * 32;
      bf16_t* dst = KC + ((size_t)gr * 8 + h) * 96 + 64;
#pragma unroll
      for (int q = 0; q < 4; ++q) { const f32x4 a = *(const f32x4*)(kr + q * 8), b = *(const f32x4*)(kr + q * 8 + 4);
        f32x4 oa = a, ob = b;
        if (lat) { const f32x4 c0 = *(const f32x4*)(rp + q * 8), c1 = *(const f32x4*)(rp + q * 8 + 4);
          oa[0] = a[0] * c0[0] - a[1] * c0[1]; oa[1] = a[1] * c0[0] + a[0] * c0[1]; oa[2] = a[2] * c0[2] - a[3] * c0[3]; oa[3] = a[3] * c0[2] + a[2] * c0[3];
          ob[0] = b[0] * c1[0] - b[1] * c1[1]; ob[1] = b[1] * c1[0] + b[0] * c1[1]; ob[2] = b[2] * c1[2] - b[3] * c1[3]; ob[3] = b[3] * c1[2] + b[2] * c1[3]; }
        u32x4 w; w.x = cvt_pk(oa[0], oa[1]); w.y = cvt_pk(oa[2], oa[3]); w.z = cvt_pk(ob[0], ob[1]); w.w = cvt_pk(ob[2], ob[3]);
        *(u32x4*)(dst + q * 8) = w; } }
    __syncthreads();
    { float run = 0.f; float* out = gdir ? LGB : LGF;
#pragma unroll 8
      for (int i = 0; i < 64; ++i) { const int r = gdir ? 63 - i : i; float a = gbias;
#pragma unroll
        for (int j = 0; j < 16; ++j) a += gl[r * 32 + gdir * 16 + j] * gw[j];
        run += logsig_f(a) * (1.f / 16.f);
        out[(size_t)(r0 + r) * 256 + gcol] = run; } }
    __syncthreads();
  }
}

struct EpiUp {
  static constexpr bool PERM = true, AFTER_DRAIN = false;
  unsigned char* ws;
  __device__ __forceinline__ void operator()(const f32x4 (&acc)[2][2][4][2], const pg8::Unit& u, int wr, int wc, int fr, int fq) const {
    asm volatile("" : "+v"(fr), "+v"(fq));
    const unsigned row0 = u.pm * 256 + wr * 64 + fr; const int pn = u.pn;
    if (pn < 3) {
#pragma unroll
      for (int bj = 0; bj < 2; ++bj) {
        const unsigned c = pn * 256 + bj * 128 + wc * 32 + 8 * fq; const unsigned h = c / 96u, dp = c - h * 96u; const bool rot = dp >= 64u;
        const unsigned ro = rot ? dp - 64u : 0u;
#pragma unroll
        for (int ai = 0; ai < 2; ++ai)
#pragma unroll
          for (int m = 0; m < 4; ++m) {
            const unsigned row = row0 + ai * 128 + m * 16;
            if (row < (unsigned)NLAT) {
              const float rs = *(const float*)(ws + (unsigned)(WS_RS + row * 8u)) * QSCALE;
              f32x4 v0 = acc[ai][bj][m][0], v1 = acc[ai][bj][m][1];
              const unsigned roff = (unsigned)WS_ROPE + ((row & 4095u) * 32u + ro) * 4u;
              f32x4 c0 = *(const f32x4*)(ws + roff), c1 = *(const f32x4*)(ws + roff + 16u);
              if (!rot) { c0 = (f32x4){1.f, 0.f, 1.f, 0.f}; c1 = c0; }
              const f32x4 a = v0, b = v1;
              v0[0] = a[0] * c0[0] - a[1] * c0[1]; v0[1] = a[1] * c0[0] + a[0] * c0[1]; v0[2] = a[2] * c0[2] - a[3] * c0[3]; v0[3] = a[3] * c0[2] + a[2] * c0[3];
              v1[0] = b[0] * c1[0] - b[1] * c1[1]; v1[1] = b[1] * c1[0] + b[0] * c1[1]; v1[2] = b[2] * c1[2] - b[3] * c1[3]; v1[3] = b[3] * c1[2] + b[2] * c1[3];
              v0 = v0 * rs; v1 = v1 * rs;
              u32x4 w; w.x = cvt_pk(v0[0], v0[1]); w.y = cvt_pk(v0[2], v0[3]); w.z = cvt_pk(v1[0], v1[1]); w.w = cvt_pk(v1[2], v1[3]);
              *(u32x4*)(ws + (unsigned)(WS_QC + ((row * 8u + h) * 96u + dp) * 2u)) = w;
            }
            asm volatile("" ::: "memory");
          }
      }
    } else {
#pragma unroll
      for (int bj = 0; bj < 2; ++bj) {
        const unsigned c = (pn - 3) * 256 + bj * 128 + wc * 32 + 8 * fq; const unsigned h = c >> 7, d = c & 127u;
        const unsigned dbase = d < 64u ? (unsigned)WS_KC + (h * 96u + d) * 2u : (unsigned)WS_VC + (h * 64u + (d - 64u)) * 2u; const unsigned ldb = d < 64u ? 1536u : 1024u;
#pragma unroll
        for (int ai = 0; ai < 2; ++ai)
#pragma unroll
          for (int m = 0; m < 4; ++m) {
            const unsigned row = row0 + ai * 128 + m * 16; const float rs = *(const float*)(ws + (unsigned)(WS_RS + row * 8u + 4u));
            const f32x4 v0 = acc[ai][bj][m][0] * rs, v1 = acc[ai][bj][m][1] * rs;
            u32x4 w; w.x = cvt_pk(v0[0], v0[1]); w.y = cvt_pk(v0[2], v0[3]); w.z = cvt_pk(v1[0], v1[1]); w.w = cvt_pk(v1[2], v1[3]);
            *(u32x4*)(ws + (dbase + row * ldb)) = w;
            asm volatile("" ::: "memory");
          }
      }
    }
  }
};
__device__ __forceinline__ void phase4_gemm(const MP& p, LAS unsigned char* lds) {
  int K = 384; asm volatile("" : "+s"(K));
  pg8::Gemm g{(const bf16_t*)(p.ws + WS_A2), (const bf16_t*)(p.ws + WS_WUPT), MROWS, 1792, K};
  pg8::StaticOrder S; S.init(MROWS, 1792, gridDim.x, blockIdx.x);
  EpiUp E{p.ws};
  pg8::gemm_phase<EpiUp, pg8::StaticOrder, true, true>(lds, g, S, E);
}

__global__ void bridge2a_k(const unsigned char* ws, float* Qc, float* Kc, float* kv, int b) {
  const int r = blockIdx.x; const int gr = grow(b, r);
  const bf16_t* QC = (const bf16_t*)(ws + WS_QC); const bf16_t* KC = (const bf16_t*)(ws + WS_KC); const bf16_t* VC = (const bf16_t*)(ws + WS_VC);
  for (int e = threadIdx.x; e < 768; e += 256) {
    Kc[(size_t)r * 768 + e] = bf2f(KC[(size_t)gr * 768 + e]);
    if (r < SEQ) Qc[(size_t)r * 768 + e] = bf2f(QC[(size_t)gr * 768 + e]) * (1.f / 1.4426950408889634f) * 9.797958971132712f;
  }
  for (int e = threadIdx.x; e < 512; e += 256) { const int h = e >> 6, d = e & 63; kv[(size_t)r * 1024 + h * 128 + 64 + d] = bf2f(VC[(size_t)gr * 512 + e]); }
}
}
namespace mk {
namespace att {
typedef short s16x4 __attribute__((ext_vector_type(4)));
constexpr int NW = 8, QBLK = 32, KVBLK = 64, NT = 68;
constexpr int KROWB = 208;
constexpr int SHM_K = KVBLK * KROWB;
constexpr int SHM_V = KVBLK * 64 * 2;
constexpr int LDS_V = 0, LDS_K = 2 * SHM_V, LDS_WS = LDS_K + 2 * SHM_K, LDS_ATT = LDS_WS + NW * 64 * 4;
constexpr float THR = 8.f;
#define SBAR() __builtin_amdgcn_sched_barrier(0)
__device__ __forceinline__ int crow(int r, int hi) { return (r & 3) + 8 * (r >> 2) + 4 * hi; }

__device__ __forceinline__ void partialSM(f32x16& p0, f32x16& p1, float& m_reg, float& mn, float& alpha) {
  float pmax = p0[0];
#pragma unroll
  for (int r = 1; r < 16; ++r) pmax = fmaxf(pmax, p0[r]);
#pragma unroll
  for (int r = 0; r < 16; ++r) pmax = fmaxf(pmax, p1[r]);
  { auto rr = __builtin_amdgcn_permlane32_swap(__float_as_uint(pmax), __float_as_uint(pmax), false, false);
    pmax = fmaxf(__uint_as_float(rr[0]), __uint_as_float(rr[1])); }
  if (__builtin_expect(__all(pmax - m_reg <= THR), 1)) { mn = m_reg; alpha = 1.f; }
  else { mn = fmaxf(m_reg, pmax); alpha = __builtin_amdgcn_exp2f(m_reg - mn); m_reg = mn; }
#pragma unroll
  for (int r = 0; r < 16; ++r) p0[r] = p0[r] - mn;
#pragma unroll
  for (int r = 0; r < 16; ++r) p1[r] = p1[r] - mn;
#pragma unroll
  for (int r = 0; r < 16; ++r) p0[r] = __builtin_amdgcn_exp2f(p0[r]);
}
__device__ __forceinline__ void finishSM(f32x16& p0, f32x16& p1, float alpha, float& l_reg, bf16x8& pa0, bf16x8& pa1, bf16x8& pa2, bf16x8& pa3) {
#pragma unroll
  for (int r = 0; r < 16; ++r) p1[r] = __builtin_amdgcn_exp2f(p1[r]);
  float ps = 0;
#pragma unroll
  for (int r = 0; r < 16; ++r) ps += p0[r];
#pragma unroll
  for (int r = 0; r < 16; ++r) ps += p1[r];
  { auto rr = __builtin_amdgcn_permlane32_swap(__float_as_uint(ps), __float_as_uint(ps), false, false);
    ps = __uint_as_float(rr[0]) + __uint_as_float(rr[1]); }
  l_reg = l_reg * alpha + ps;
#define PK4(P, BASE, OUT) do { unsigned a0 = cvt_pk(P[BASE + 0], P[BASE + 1]), a1 = cvt_pk(P[BASE + 2], P[BASE + 3]);   \
    unsigned b0 = cvt_pk(P[BASE + 4], P[BASE + 5]), b1 = cvt_pk(P[BASE + 6], P[BASE + 7]);                              \
    auto r0 = __builtin_amdgcn_permlane32_swap(a0, b0, false, false); auto r1 = __builtin_amdgcn_permlane32_swap(a1, b1, false, false); \
    u32x4 w = {r0[0], r1[0], r0[1], r1[1]}; OUT = __builtin_bit_cast(bf16x8, w); } while (0)
  PK4(p0, 0, pa0); PK4(p0, 8, pa1); PK4(p1, 0, pa2); PK4(p1, 8, pa3);
#undef PK4
}
__device__ __forceinline__ void qkt(f32x16& p0, f32x16& p1, const LAS unsigned char* Ks, const bf16x8* qr, int r32, int hi) {
  p0 = f32x16{}; p1 = f32x16{};
#pragma unroll
  for (int d0 = 0; d0 < 6; ++d0) { const int cb = (d0 * 16 + hi * 8) * 2;
    const bf16x8 b0 = *(const LAS bf16x8*)(Ks + r32 * KROWB + cb);
    const bf16x8 b1 = *(const LAS bf16x8*)(Ks + (32 + r32) * KROWB + cb);
    p0 = __builtin_amdgcn_mfma_f32_32x32x16_bf16(b0, qr[d0], p0, 0, 0, 0);
    p1 = __builtin_amdgcn_mfma_f32_32x32x16_bf16(b1, qr[d0], p1, 0, 0, 0); }
}
__device__ __forceinline__ int v_st(int k, int c) { const int kk = (k & ~0xC) | ((k & 4) << 1) | ((k & 8) >> 1); return ((kk >> 3) * 2 + (c >> 5)) * 512 + ((kk & 7) * 32 + (c & 31)) * 2; }
__device__ __forceinline__ int v_rd_base(int lane) { return ((lane & 3) << 3) | (((lane >> 2) & 3) << 6) | (((lane >> 4) & 1) << 5) | (((lane >> 5) & 1) << 8); }
constexpr int v_rd_off(int d0, int ks, int half) { return d0 * 512 + ks * 2048 + half * 1024; }
template <int OFF> __device__ __forceinline__ s16x4 tr_read(int vb) {
  s16x4 r; asm volatile("ds_read_b64_tr_b16 %0, %1 offset:%2" : "=&v"(r) : "v"(vb), "i"(OFF) : "memory"); return r;
}
template <int D0> __device__ __forceinline__ void pv_one(f32x16& od, int vb, bf16x8 pa0, bf16x8 pa1, bf16x8 pa2, bf16x8 pa3) {
  const s16x4 l0 = tr_read<v_rd_off(D0, 0, 0)>(vb), h0 = tr_read<v_rd_off(D0, 0, 1)>(vb), l1 = tr_read<v_rd_off(D0, 1, 0)>(vb), h1 = tr_read<v_rd_off(D0, 1, 1)>(vb);
  const s16x4 l2 = tr_read<v_rd_off(D0, 2, 0)>(vb), h2 = tr_read<v_rd_off(D0, 2, 1)>(vb), l3 = tr_read<v_rd_off(D0, 3, 0)>(vb), h3 = tr_read<v_rd_off(D0, 3, 1)>(vb);
  asm volatile("s_waitcnt lgkmcnt(0)" ::: "memory"); SBAR();
#define PK(L, H) (bf16x8){L[0], L[1], L[2], L[3], H[0], H[1], H[2], H[3]}
  od = __builtin_amdgcn_mfma_f32_32x32x16_bf16(pa0, PK(l0, h0), od, 0, 0, 0);
  od = __builtin_amdgcn_mfma_f32_32x32x16_bf16(pa1, PK(l1, h1), od, 0, 0, 0);
  od = __builtin_amdgcn_mfma_f32_32x32x16_bf16(pa2, PK(l2, h2), od, 0, 0, 0);
  od = __builtin_amdgcn_mfma_f32_32x32x16_bf16(pa3, PK(l3, h3), od, 0, 0, 0);
#undef PK
}
__device__ __forceinline__ void pv_d0(f32x16* o, int vb, bf16x8 pa0, bf16x8 pa1, bf16x8 pa2, bf16x8 pa3) {
  pv_one<0>(o[0], vb, pa0, pa1, pa2, pa3); pv_one<1>(o[1], vb, pa0, pa1, pa2, pa3);
}

__device__ __forceinline__ void attn_unit(const bf16_t* __restrict__ QC, const bf16_t* __restrict__ KC, const bf16_t* __restrict__ VC, bf16_t* __restrict__ MIX,
                                          int b, int h, int qb, LAS unsigned char* lds) {
  const int tid = threadIdx.x, wid = tid >> 6, lane = tid & 63, r32 = lane & 31, hi = lane >> 5;
  LAS unsigned char* V_lds = lds + LDS_V; LAS unsigned char* K_lds = lds + LDS_K;
  LAS float* wsf = (LAS float*)(lds + LDS_WS) + wid * 64; LAS float* li_l = wsf; LAS float* al_l = wsf + 32;
  float m_reg = -1e30f, l_reg = 0; f32x16 o[2] = {}; bf16x8 qr[6];
  const int qrow = b * SEQ + qb * 256 + wid * QBLK + r32;
  const bf16_t* Qw = QC + ((size_t)qrow * 8 + h) * 96 + hi * 8;
#pragma unroll
  for (int d0 = 0; d0 < 6; ++d0) qr[d0] = *(const bf16x8*)(Qw + d0 * 16);
  const int sr = tid >> 3, sc = (tid & 7) * 8, vst = v_st(sr, sc);
  const int k0r = tid / 12, k0c = tid - k0r * 12; const int id1 = 512 + (tid & 255); const int k1r = id1 / 12, k1c = id1 - k1r * 12; const bool w1 = tid < 256;
  const int kst0 = k0r * KROWB + k0c * 16, kst1 = k1r * KROWB + k1c * 16;
  const int vb0 = (int)(unsigned)(size_t)V_lds + v_rd_base(lane);
  const bf16_t* Kh = KC + (size_t)h * 96; const bf16_t* Vh = VC + (size_t)h * 64;
  struct { bf16x8 vs, ks0, ks1; } sr_[2];
#define TROW(j) ((j) < 64 ? b * SEQ + (j) * 64 : NLAT + b * CTXL + ((j) - 64) * 64)
#define SLOAD(i, j) do { const int tr_ = TROW(j); sr_[i].vs = *(const bf16x8*)(Vh + (size_t)(tr_ + sr) * 512 + sc); \
    sr_[i].ks0 = *(const bf16x8*)(Kh + (size_t)(tr_ + k0r) * 768 + k0c * 8); sr_[i].ks1 = *(const bf16x8*)(Kh + (size_t)(tr_ + k1r) * 768 + k1c * 8); } while (0)
#define SWRITE(bb, i) do { *(LAS bf16x8*)(V_lds + (bb) * SHM_V + vst) = sr_[i].vs; *(LAS bf16x8*)(K_lds + (bb) * SHM_K + kst0) = sr_[i].ks0; \
    if (w1) *(LAS bf16x8*)(K_lds + (bb) * SHM_K + kst1) = sr_[i].ks1; } while (0)
#define SWAIT() asm volatile("s_waitcnt vmcnt(3)" ::: "memory")
#define RESC(a) do { if (__any((a) < 1.f)) { if (hi == 0) al_l[r32] = (a); asm volatile("s_waitcnt lgkmcnt(0)" ::: "memory"); \
    _Pragma("unroll") for (int d = 0; d < 2; ++d) _Pragma("unroll") for (int r = 0; r < 16; ++r) o[d][r] *= al_l[crow(r, hi)]; } } while (0)
  f32x16 pA0, pA1, pB0, pB1; float mnA, mnB, alA, alB; bf16x8 pa0, pa1, pa2, pa3;
  constexpr int SE = 0, SO = 1;
  SLOAD(SE, 0); asm volatile("s_waitcnt vmcnt(0)" ::: "memory"); SWRITE(0, SE); __syncthreads();
  qkt(pA0, pA1, K_lds, qr, r32, hi); partialSM(pA0, pA1, m_reg, mnA, alA);
  SLOAD(SO, 1); SLOAD(SE, 2);
  SWAIT(); SWRITE(1, SO); __syncthreads();
  for (int j = 1; j + 1 < NT; j += 2) {
    SBAR(); qkt(pB0, pB1, K_lds + SHM_K, qr, r32, hi);
    finishSM(pA0, pA1, alA, l_reg, pa0, pa1, pa2, pa3); SBAR();
    SLOAD(SO, j + 2); SBAR();
    pv_d0(o, vb0, pa0, pa1, pa2, pa3); partialSM(pB0, pB1, m_reg, mnB, alB);
    __syncthreads(); SWAIT(); SWRITE(0, SE);
    RESC(alB); __syncthreads();
    SBAR(); qkt(pA0, pA1, K_lds, qr, r32, hi);
    finishSM(pB0, pB1, alB, l_reg, pa0, pa1, pa2, pa3); SBAR();
    if (j + 3 < NT) SLOAD(SE, j + 3); SBAR();
    pv_d0(o, vb0 + SHM_V, pa0, pa1, pa2, pa3); partialSM(pA0, pA1, m_reg, mnA, alA);
    __syncthreads(); SWAIT(); SWRITE(1, SO);
    RESC(alA); __syncthreads();
  }
  SBAR(); qkt(pB0, pB1, K_lds + SHM_K, qr, r32, hi);
  finishSM(pA0, pA1, alA, l_reg, pa0, pa1, pa2, pa3); SBAR();
  pv_d0(o, vb0, pa0, pa1, pa2, pa3); partialSM(pB0, pB1, m_reg, mnB, alB);
  __syncthreads(); RESC(alB);
  finishSM(pB0, pB1, alB, l_reg, pa0, pa1, pa2, pa3); SBAR();
  pv_d0(o, vb0 + SHM_V, pa0, pa1, pa2, pa3);
  if (hi == 0) li_l[r32] = l_reg; asm volatile("s_waitcnt lgkmcnt(0)" ::: "memory");
  bf16_t* Ow = MIX + (size_t)(b * SEQ + qb * 256 + wid * QBLK) * 1024 + 512 + h * 64;
#pragma unroll
  for (int r = 0; r < 16; ++r) { const int orow = crow(r, hi); const float rl = __builtin_amdgcn_rcpf(li_l[orow]);
#pragma unroll
    for (int d0 = 0; d0 < 2; ++d0) { const float v = o[d0][r] * rl; const unsigned w = cvt_pk(v, v); Ow[(size_t)orow * 1024 + d0 * 32 + r32] = (bf16_t)(w & 0xffffu); } }
  __syncthreads();
#undef TROW
#undef SLOAD
#undef SWRITE
#undef SWAIT
#undef RESC
}
}

__device__ __forceinline__ void phase5_attn(const MP& p, LAS unsigned char* lds) {
  const bf16_t* QC = (const bf16_t*)(p.ws + WS_QC); const bf16_t* KC = (const bf16_t*)(p.ws + WS_KC); const bf16_t* VC = (const bf16_t*)(p.ws + WS_VC);
  bf16_t* MIX = (bf16_t*)(p.ws + WS_MIX);
  const int bid = blockIdx.x, G = gridDim.x;
  if (G == 256) {
    const int xcd = bid & 7, slot = bid >> 3, bhl = slot >> 4, qb = slot & 15;
    for (int i = 0; i < 4; ++i) { const int bh = (i * 2 + bhl) * 8 + xcd; att::attn_unit(QC, KC, VC, MIX, bh >> 3, bh & 7, qb, lds); }
  } else {
    for (int u = bid; u < 1024; u += G) { const int bh = u >> 4, qb = u & 15; att::attn_unit(QC, KC, VC, MIX, bh >> 3, bh & 7, qb, lds); }
  }
}

__global__ void bridge2b_k(const unsigned char* ws, float* mix, int b, int c0, int c1) {
  const int r = blockIdx.x; const bf16_t* MIX = (const bf16_t*)(ws + WS_MIX);
  for (int c = c0 + threadIdx.x; c < c1; c += 256) mix[(size_t)r * 1024 + c] = bf2f(MIX[(size_t)(b * SEQ + r) * 1024 + c]);
}
}
namespace mk {
namespace gla {
constexpr int RS144 = 144;
constexpr int L_VT = 0;
constexpr int L_K1 = 18432, L_K2 = L_K1 + 9216;
constexpr int L_O = L_K2 + 9216;
constexpr int OST = 132;
__device__ __forceinline__ int crow(int r, int hi) { return (r & 3) + 8 * (r >> 2) + 4 * hi; }
__device__ __forceinline__ int cid_row0(int b, int cid) { return cid < 4 ? NLAT + b * CTXL + cid * 64 : b * SEQ + (cid - 4) * 64; }
__device__ __forceinline__ size_t ds_off(int b, int h, int dir, int cid) { return ((size_t)(((b * 4 + h) * 2 + dir) * 68 + cid)) * 8192; }

__device__ __forceinline__ void stage_vt(const bf16_t* VG, int row0, int h, LAS unsigned char* vt) {
  const int tid = threadIdx.x;
#pragma unroll
  for (int i = 0; i < 2; ++i) { const int ch = tid + i * 512, j = ch >> 4, v0 = (ch & 15) * 8;
    const u32x4 w = *(const u32x4*)(VG + (size_t)(row0 + j) * 512 + h * 128 + v0);
    LAS unsigned short* d = (LAS unsigned short*)(vt + v0 * RS144 + j * 2);
    d[0 * 72] = (unsigned short)(w.x & 0xffff); d[1 * 72] = (unsigned short)(w.x >> 16); d[2 * 72] = (unsigned short)(w.y & 0xffff); d[3 * 72] = (unsigned short)(w.y >> 16);
    d[4 * 72] = (unsigned short)(w.z & 0xffff); d[5 * 72] = (unsigned short)(w.z >> 16); d[6 * 72] = (unsigned short)(w.w & 0xffff); d[7 * 72] = (unsigned short)(w.w >> 16); }
}

__device__ __forceinline__ void stage1_unit(const MP& p, int b, int h, int cid, LAS unsigned char* lds) {
  const int tid = threadIdx.x, wid = tid >> 6, lane = tid & 63, r32 = lane & 31, hi = lane >> 5;
  unsigned char* ws = p.ws; const bf16_t* KG = (const bf16_t*)(ws + WS_KG); const bf16_t* VG = (const bf16_t*)(ws + WS_VG);
  const float* LGF = (const float*)(ws + WS_LGF); const float* LGB = (const float*)(ws + WS_LGB); bf16_t* DS = (bf16_t*)(ws + WS_DS);
  const int row0 = cid_row0(b, cid);
  stage_vt(VG, row0, h, lds + L_VT);
  { const int j = tid >> 3, k0 = (tid & 7) * 8; const u32x4 kw = *(const u32x4*)(KG + (size_t)(row0 + j) * 256 + h * 64 + k0);
    const float* bf = LGF + (size_t)(row0 + j) * 256 + h * 64 + k0; const float* bfe = LGF + (size_t)(row0 + 63) * 256 + h * 64 + k0;
    const float* bb = LGB + (size_t)(row0 + j) * 256 + h * 64 + k0; const float* bbe = LGB + (size_t)row0 * 256 + h * 64 + k0;
    const f32x4 f0 = *(const f32x4*)bf, f1 = *(const f32x4*)(bf + 4), fe0 = *(const f32x4*)bfe, fe1 = *(const f32x4*)(bfe + 4);
    const f32x4 g0 = *(const f32x4*)bb, g1 = *(const f32x4*)(bb + 4), ge0 = *(const f32x4*)bbe, ge1 = *(const f32x4*)(bbe + 4);
    float kv[8] = {bflo(kw.x), bfhi(kw.x), bflo(kw.y), bfhi(kw.y), bflo(kw.z), bfhi(kw.z), bflo(kw.w), bfhi(kw.w)};
    float ef[8] = {fe0[0] - f0[0], fe0[1] - f0[1], fe0[2] - f0[2], fe0[3] - f0[3], fe1[0] - f1[0], fe1[1] - f1[1], fe1[2] - f1[2], fe1[3] - f1[3]};
    float eb[8] = {ge0[0] - g0[0], ge0[1] - g0[1], ge0[2] - g0[2], ge0[3] - g0[3], ge1[0] - g1[0], ge1[1] - g1[1], ge1[2] - g1[2], ge1[3] - g1[3]};
    LAS unsigned short* d1 = (LAS unsigned short*)(lds + L_K1 + k0 * RS144 + j * 2); LAS unsigned short* d2 = (LAS unsigned short*)(lds + L_K2 + k0 * RS144 + j * 2);
#pragma unroll
    for (int i = 0; i < 8; ++i) { const float a = kv[i] * __expf(ef[i]), c = kv[i] * __expf(eb[i]);
      d1[i * 72] = (unsigned short)(cvt_pk(a, a) & 0xffff); d2[i * 72] = (unsigned short)(cvt_pk(c, c) & 0xffff); } }
  __syncthreads();
  { const int dir = wid >> 2, mt = wid & 3;
    const LAS unsigned char* vt = lds + L_VT + (mt * 32 + r32) * RS144 + hi * 16; const LAS unsigned char* kd = lds + (dir ? L_K2 : L_K1) + r32 * RS144 + hi * 16;
    f32x16 acc0 = {}, acc1 = {};
#pragma unroll
    for (int s = 0; s < 4; ++s) { const bf16x8 a = *(const LAS bf16x8*)(vt + s * 32);
      const bf16x8 b0 = *(const LAS bf16x8*)(kd + s * 32), b1 = *(const LAS bf16x8*)(kd + 32 * RS144 + s * 32);
      acc0 = __builtin_amdgcn_mfma_f32_32x32x16_bf16(a, b0, acc0, 0, 0, 0); acc1 = __builtin_amdgcn_mfma_f32_32x32x16_bf16(a, b1, acc1, 0, 0, 0); }
    bf16_t* out = DS + ds_off(b, h, dir, cid);
#pragma unroll
    for (int r = 0; r < 16; ++r) { const int v = mt * 32 + crow(r, hi);
      out[v * 64 + r32] = (bf16_t)(cvt_pk(acc0[r], acc0[r]) & 0xffff); out[v * 64 + 32 + r32] = (bf16_t)(cvt_pk(acc1[r], acc1[r]) & 0xffff); } }
  __syncthreads();
}
__device__ __forceinline__ void stage1(const MP& p, LAS unsigned char* lds) {
  for (int u = blockIdx.x; u < 8 * 4 * 68; u += gridDim.x) { const int cid = u % 68, bh = u / 68; stage1_unit(p, bh >> 2, bh & 3, cid, lds); }
}

template <bool DRY> __device__ __forceinline__ void stage2(const MP& p) {
  unsigned char* ws = p.ws; const float* LGF = (const float*)(ws + WS_LGF); const float* LGB = (const float*)(ws + WS_LGB); bf16_t* DS = (bf16_t*)(ws + WS_DS);
  for (int e = blockIdx.x * NTH + threadIdx.x; e < 131072; e += gridDim.x * NTH) {
    const int k4 = (e & 15) * 4, v = (e >> 4) & 127, seq = e >> 11, dir = seq & 1, h = (seq >> 1) & 3, b = seq >> 3;
    const float* LG = dir ? LGB : LGF;
    float s0 = 0.f, s1 = 0.f, s2 = 0.f, s3 = 0.f;
    for (int n0 = 0; n0 < 68; n0 += 4) {
      u32x2 dsv[4]; f32x4 lg[4]; bf16_t* ptr[4];
#pragma unroll
      for (int i = 0; i < 4; ++i) { const int n = n0 + i; const int cid = dir ? (n < 4 ? 3 - n : 71 - n) : n;
        const int row0 = cid_row0(b, cid); ptr[i] = DS + ds_off(b, h, dir, cid) + v * 64 + k4;
        dsv[i] = *(const u32x2*)ptr[i]; lg[i] = *(const f32x4*)(LG + (size_t)(row0 + (dir ? 0 : 63)) * 256 + h * 64 + k4); }
#pragma unroll
      for (int i = 0; i < 4; ++i) { u32x2 o; o.x = cvt_pk(s0, s1); o.y = cvt_pk(s2, s3); if (!DRY) *(u32x2*)ptr[i] = o;
        s0 = __expf(lg[i][0]) * s0 + bflo(dsv[i].x); s1 = __expf(lg[i][1]) * s1 + bfhi(dsv[i].x); s2 = __expf(lg[i][2]) * s2 + bflo(dsv[i].y); s3 = __expf(lg[i][3]) * s3 + bfhi(dsv[i].y); }
    }
    if (DRY && s0 + s1 + s2 + s3 == 12345.678f) *(float*)(p.ws + WS_BAR + 128) = s0;
  }
}

__device__ __forceinline__ void stage3_unit(const MP& p, int b, int h, int c, LAS unsigned char* lds) {
  const int tid = threadIdx.x, wid = tid >> 6, lane = tid & 63, r32 = lane & 31, hi = lane >> 5;
  unsigned char* ws = p.ws; const bf16_t* QG = (const bf16_t*)(ws + WS_QG); const bf16_t* KG = (const bf16_t*)(ws + WS_KG); const bf16_t* VG = (const bf16_t*)(ws + WS_VG);
  const bf16_t* RG = (const bf16_t*)(ws + WS_RG); const float* LGF = (const float*)(ws + WS_LGF); const float* LGB = (const float*)(ws + WS_LGB);
  const bf16_t* DS = (const bf16_t*)(ws + WS_DS); bf16_t* MIX = (bf16_t*)(ws + WS_MIX);
  const int row0 = b * SEQ + c * 64, cid = c + 4;
  stage_vt(VG, row0, h, lds + L_VT);
  { const int j = tid >> 3, k0 = (tid & 7) * 8; const u32x4 kw = *(const u32x4*)(KG + (size_t)(row0 + j) * 256 + h * 64 + k0);
    const float* bf = LGF + (size_t)(row0 + j) * 256 + h * 64 + k0; const float* bb = LGB + (size_t)(row0 + j) * 256 + h * 64 + k0;
    const f32x4 f0 = *(const f32x4*)bf, f1 = *(const f32x4*)(bf + 4), g0 = *(const f32x4*)bb, g1 = *(const f32x4*)(bb + 4);
    float kv[8] = {bflo(kw.x), bfhi(kw.x), bflo(kw.y), bfhi(kw.y), bflo(kw.z), bfhi(kw.z), bflo(kw.w), bfhi(kw.w)};
    float ef[8] = {f0[0], f0[1], f0[2], f0[3], f1[0], f1[1], f1[2], f1[3]}; float eb[8] = {g0[0], g0[1], g0[2], g0[3], g1[0], g1[1], g1[2], g1[3]};
    float a[8], cc[8];
#pragma unroll
    for (int i = 0; i < 8; ++i) { a[i] = kv[i] * __expf(-ef[i]); cc[i] = kv[i] * __expf(-eb[i]); }
    u32x4 w1, w2; w1.x = cvt_pk(a[0], a[1]); w1.y = cvt_pk(a[2], a[3]); w1.z = cvt_pk(a[4], a[5]); w1.w = cvt_pk(a[6], a[7]);
    w2.x = cvt_pk(cc[0], cc[1]); w2.y = cvt_pk(cc[2], cc[3]); w2.z = cvt_pk(cc[4], cc[5]); w2.w = cvt_pk(cc[6], cc[7]);
    *(LAS u32x4*)(lds + L_K1 + j * RS144 + k0 * 2) = w1; *(LAS u32x4*)(lds + L_K2 + j * RS144 + k0 * 2) = w2; }
  __syncthreads();
  { const int dir = wid >> 2, half = (wid >> 1) & 1, vh = wid & 1; const int i = half * 32 + r32;
    bf16x8 qr[4];
    { const bf16_t* qp = QG + (size_t)(row0 + i) * 256 + h * 64 + hi * 8; const float* bp = (dir ? LGB : LGF) + (size_t)(row0 + i) * 256 + h * 64 + hi * 8;
#pragma unroll
      for (int s = 0; s < 4; ++s) { const u32x4 qw = *(const u32x4*)(qp + s * 16); const f32x4 b0 = *(const f32x4*)(bp + s * 16), b1 = *(const f32x4*)(bp + s * 16 + 4);
        u32x4 w; w.x = cvt_pk(bflo(qw.x) * __expf(b0[0]) * 0.125f, bfhi(qw.x) * __expf(b0[1]) * 0.125f); w.y = cvt_pk(bflo(qw.y) * __expf(b0[2]) * 0.125f, bfhi(qw.y) * __expf(b0[3]) * 0.125f);
        w.z = cvt_pk(bflo(qw.z) * __expf(b1[0]) * 0.125f, bfhi(qw.z) * __expf(b1[1]) * 0.125f); w.w = cvt_pk(bflo(qw.w) * __expf(b1[2]) * 0.125f, bfhi(qw.w) * __expf(b1[3]) * 0.125f);
        qr[s] = __builtin_bit_cast(bf16x8, w); } }
    f32x16 p0 = {}, p1 = {};
    { const LAS unsigned char* ke = lds + (dir ? L_K2 : L_K1) + r32 * RS144 + hi * 16;
#pragma unroll
      for (int s = 0; s < 4; ++s) { const bf16x8 k0 = *(const LAS bf16x8*)(ke + s * 32), k1 = *(const LAS bf16x8*)(ke + 32 * RS144 + s * 32);
        p0 = __builtin_amdgcn_mfma_f32_32x32x16_bf16(k0, qr[s], p0, 0, 0, 0); p1 = __builtin_amdgcn_mfma_f32_32x32x16_bf16(k1, qr[s], p1, 0, 0, 0); } }
#pragma unroll
    for (int r = 0; r < 16; ++r) { const int j0 = crow(r, hi), j1 = 32 + j0;
      const bool k0 = dir ? (j0 >= i) : (j0 <= i), k1 = dir ? (j1 >= i) : (j1 <= i);
      p0[r] = k0 ? p0[r] : 0.f; p1[r] = k1 ? p1[r] : 0.f; }
    bf16x8 pa0, pa1, pa2, pa3;
#define PK4(P, BASE, OUT) do { unsigned a0 = cvt_pk(P[BASE + 0], P[BASE + 1]), a1 = cvt_pk(P[BASE + 2], P[BASE + 3]);   \
    unsigned b0 = cvt_pk(P[BASE + 4], P[BASE + 5]), b1 = cvt_pk(P[BASE + 6], P[BASE + 7]);                              \
    auto r0 = __builtin_amdgcn_permlane32_swap(a0, b0, false, false); auto r1 = __builtin_amdgcn_permlane32_swap(a1, b1, false, false); \
    u32x4 w = {r0[0], r1[0], r0[1], r1[1]}; OUT = __builtin_bit_cast(bf16x8, w); } while (0)
    PK4(p0, 0, pa0); PK4(p0, 8, pa1); PK4(p1, 0, pa2); PK4(p1, 8, pa3);
#undef PK4
    f32x16 o[2] = {};
    const bf16_t* sp = DS + ds_off(b, h, dir, cid);
#pragma unroll
    for (int d0 = 0; d0 < 2; ++d0) { const int v = vh * 64 + d0 * 32 + r32;
      const LAS unsigned char* vt = lds + L_VT + v * RS144 + hi * 16; const bf16_t* sv = sp + v * 64 + hi * 8;
      const bf16x8 v0 = *(const LAS bf16x8*)(vt), v1 = *(const LAS bf16x8*)(vt + 32), v2 = *(const LAS bf16x8*)(vt + 64), v3 = *(const LAS bf16x8*)(vt + 96);
      const bf16x8 s0 = *(const bf16x8*)(sv), s1 = *(const bf16x8*)(sv + 16), s2 = *(const bf16x8*)(sv + 32), s3 = *(const bf16x8*)(sv + 48);
      o[d0] = __builtin_amdgcn_mfma_f32_32x32x16_bf16(pa0, v0, o[d0], 0, 0, 0); o[d0] = __builtin_amdgcn_mfma_f32_32x32x16_bf16(pa1, v1, o[d0], 0, 0, 0);
      o[d0] = __builtin_amdgcn_mfma_f32_32x32x16_bf16(pa2, v2, o[d0], 0, 0, 0); o[d0] = __builtin_amdgcn_mfma_f32_32x32x16_bf16(pa3, v3, o[d0], 0, 0, 0);
      o[d0] = __builtin_amdgcn_mfma_f32_32x32x16_bf16(qr[0], s0, o[d0], 0, 0, 0); o[d0] = __builtin_amdgcn_mfma_f32_32x32x16_bf16(qr[1], s1, o[d0], 0, 0, 0);
      o[d0] = __builtin_amdgcn_mfma_f32_32x32x16_bf16(qr[2], s2, o[d0], 0, 0, 0); o[d0] = __builtin_amdgcn_mfma_f32_32x32x16_bf16(qr[3], s3, o[d0], 0, 0, 0); }
    LAS float* ob = (LAS float*)(lds + L_O) + dir * 64 * OST;
#pragma unroll
    for (int r = 0; r < 16; ++r) { const int row = half * 32 + crow(r, hi);
      ob[row * OST + vh * 64 + r32] = o[0][r]; ob[row * OST + vh * 64 + 32 + r32] = o[1][r]; } }
  __syncthreads();
  { const int row = tid >> 3, seg = tid & 7; const LAS float* of = (const LAS float*)(lds + L_O) + row * OST + seg * 16; const LAS float* obk = of + 64 * OST;
    float x[16]; float sq = 0.f;
#pragma unroll
    for (int q = 0; q < 4; ++q) { const f32x4 a = *(const LAS f32x4*)(of + q * 4), bq = *(const LAS f32x4*)(obk + q * 4);
#pragma unroll
      for (int t = 0; t < 4; ++t) { x[q * 4 + t] = a[t] + bq[t]; sq += x[q * 4 + t] * x[q * 4 + t]; } }
    sq += __shfl_xor(sq, 1); sq += __shfl_xor(sq, 2); sq += __shfl_xor(sq, 4);
    const float rstd = rsqrtf(sq * (1.f / 128.f) + EPS);
    const bf16_t* rp = RG + (size_t)(row0 + row) * 512 + h * 128 + seg * 16; const float* gp = p.in[I_GLAG] + seg * 16;
    const u32x4 r0 = *(const u32x4*)rp, r1 = *(const u32x4*)(rp + 8);
    const float rr[16] = {bflo(r0.x), bfhi(r0.x), bflo(r0.y), bfhi(r0.y), bflo(r0.z), bfhi(r0.z), bflo(r0.w), bfhi(r0.w), bflo(r1.x), bfhi(r1.x), bflo(r1.y), bfhi(r1.y), bflo(r1.z), bfhi(r1.z), bflo(r1.w), bfhi(r1.w)};
    float y[16];
#pragma unroll
    for (int t = 0; t < 16; ++t) y[t] = x[t] * rstd * gp[t] * (rr[t] / (1.f + __expf(-rr[t])));
    u32x4 w0, w1; w0.x = cvt_pk(y[0], y[1]); w0.y = cvt_pk(y[2], y[3]); w0.z = cvt_pk(y[4], y[5]); w0.w = cvt_pk(y[6], y[7]);
    w1.x = cvt_pk(y[8], y[9]); w1.y = cvt_pk(y[10], y[11]); w1.z = cvt_pk(y[12], y[13]); w1.w = cvt_pk(y[14], y[15]);
    bf16_t* dst = MIX + (size_t)(row0 + row) * 1024 + h * 128 + seg * 16; *(u32x4*)dst = w0; *(u32x4*)(dst + 8) = w1; }
  __syncthreads();
}
__device__ __forceinline__ void stage3(const MP& p, LAS unsigned char* lds) {
  for (int u = blockIdx.x; u < 8 * 4 * 64; u += gridDim.x) { const int c = u & 63, bh = u >> 6; stage3_unit(p, bh >> 2, bh & 3, c, lds); }
}
}
}
namespace mk {
constexpr int CW_NT = 32, CW_TB = 64;
constexpr int MAXT = 152;

__device__ __forceinline__ void prep_expert_weights(const MP& p, LAS unsigned char* lds) {
  LAS float* t = (LAS float*)lds; int cursor = 0;
  wprep(SrcW1{p.in[I_WEG], p.in[I_WEU]}, (bf16_t*)(p.ws + WS_W1T), 16 * 512, 1024, t, cursor);
  wprep(SrcW2{p.in[I_WED]}, (bf16_t*)(p.ws + WS_W2T), 24 * 1024, 512, t, cursor);
}

struct EpiOut {
  static constexpr bool PERM = false, AFTER_DRAIN = false;
  const float* x; float* out; unsigned char* ws;
  __device__ __forceinline__ void operator()(const f32x4 (&acc)[2][2][4][2], const pg8::Unit& u, int wr, int wc, int fr, int fq) const {
    asm volatile("" : "+v"(fr), "+v"(fq));
    const unsigned row0 = u.pm * 256 + wr * 64 + fr; const unsigned col0 = u.pn * 256 + wc * 32 + 4 * fq; const unsigned b = (u.pm * 256) >> 12;
    f32x4 gt[2][2];
#pragma unroll
    for (int bj = 0; bj < 2; ++bj)
#pragma unroll
      for (int n = 0; n < 2; ++n) gt[bj][n] = *(const f32x4*)(ws + (unsigned)(WS_MOD + (b * 6144u + 2048u + col0 + bj * 128 + n * 16) * 4u));
#pragma unroll
    for (int ai = 0; ai < 2; ++ai)
#pragma unroll
      for (int m = 0; m < 4; ++m) {
        const unsigned row = row0 + ai * 128 + m * 16; const unsigned eo = row * 1024u + col0; float s = 0.f, q = 0.f;
#pragma unroll
        for (int bj = 0; bj < 2; ++bj)
#pragma unroll
          for (int n = 0; n < 2; ++n) { const f32x4 xv = *(const f32x4*)(x + eo + bj * 128 + n * 16); const f32x4 z = xv * ALPHA + gt[bj][n] * acc[ai][bj][m][n];
            *(f32x4*)(out + eo + bj * 128 + n * 16) = z; s += (z[0] + z[1]) + (z[2] + z[3]); q += (z[0] * z[0] + z[1] * z[1]) + (z[2] * z[2] + z[3] * z[3]); }
        s += __shfl_xor(s, 16); s += __shfl_xor(s, 32); q += __shfl_xor(q, 16); q += __shfl_xor(q, 32);
        if (fq == 0) { f32x2 st = {s, q}; *(f32x2*)(ws + (unsigned)(WS_ST1 + (row * 16u + u.pn * 4u + wc) * 8u)) = st; }
        asm volatile("" ::: "memory");
      }
  }
};
__device__ __forceinline__ void phase7(const MP& p, LAS unsigned char* lds) {
  int K = 1024; asm volatile("" : "+s"(K));
  pg8::Gemm g{(const bf16_t*)(p.ws + WS_MIX), (const bf16_t*)(p.ws + WS_WOT), NLAT, 1024, K};
  pg8::StaticOrder S; S.init(NLAT, 1024, gridDim.x, blockIdx.x);
  EpiOut E{p.in[I_X], p.out, p.ws};
  pg8::gemm_phase<EpiOut, pg8::StaticOrder, true, true>(lds, g, S, E);
}

struct TokInfo { int bucket, pos; float wa, wb; };
template <bool SH> __device__ __forceinline__ void phase8(const MP& p, LAS unsigned char* lds) {
  const int tid = threadIdx.x, wid = tid >> 6, lane = tid & 63; unsigned char* ws = p.ws;
  LAS float* wr = (LAS float*)lds;
  LAS float* part = (LAS float*)(lds + 81920) + wid * 1280;
  LAS float* lgt = (LAS float*)(lds + 81920 + 40960);
  LAS int* tb = (LAS int*)(lds + 81920 + 40960 + 10240);
  LAS float* tw = (LAS float*)(tb + 128);
  LAS int* base = (LAS int*)(tw + 256);
  for (int e = tid; e < 1024 * 20; e += NTH) { const int j = e >> 10, k = e & 1023; wr[e] = j < 4 ? p.in[I_WRG][k * 4 + j] : p.in[I_WRE][k * 16 + (j - 4)]; }
  __syncthreads();
  float* out = p.out; float* xo = SH ? (float*)(ws + 370 * MiB) : p.out; const float* mod = (const float*)(ws + WS_MOD); bf16_t* H = (bf16_t*)(ws + (SH ? WS_MIX : WS_H)); int* cnt = (int*)(ws + WS_CNT) + (SH ? 1024 : 0);
  TokInfo* TI = (TokInfo*)(ws + (SH ? 500 * MiB : WS_TOKINFO)); const float* ST = (const float*)(ws + WS_ST1);
  for (int t0 = blockIdx.x * 128; t0 < NLAT; t0 += gridDim.x * 128) {
    const int b = t0 >> 12; const float* mb = mod + b * 6144;
    f32x4 g1[4], b1[4], sh[4], sc[4];
#pragma unroll
    for (int qd = 0; qd < 4; ++qd) { const int c = qd * 256 + lane * 4; g1[qd] = *(const f32x4*)(p.in[I_LN1G] + c); b1[qd] = *(const f32x4*)(p.in[I_LN1B] + c);
      sh[qd] = *(const f32x4*)(mb + 3072 + c); sc[qd] = *(const f32x4*)(mb + 4096 + c) + 1.f; }
    for (int i = 0; i < 16; ++i) {
      const int lt = wid * 16 + i, tok = t0 + lt;
      f32x4 z[4];
#pragma unroll
      for (int qd = 0; qd < 4; ++qd) z[qd] = *(const f32x4*)(out + (size_t)tok * 1024 + qd * 256 + lane * 4);
      float s = 0.f, q = 0.f; if (lane < 16) { const f32x2 v = *(const f32x2*)(ST + ((size_t)tok * 16 + lane) * 2); s = v[0]; q = v[1]; }
#pragma unroll
      for (int o = 1; o < 16; o <<= 1) { s += __shfl_xor(s, o); q += __shfl_xor(q, o); }
      s = __shfl(s, 0); q = __shfl(q, 0);
      const float mean = s * (1.f / 1024.f), rstd = rsqrtf(fmaxf(q * (1.f / 1024.f) - mean * mean, 0.f) + EPS);
      float lg[20];
#pragma unroll
      for (int j = 0; j < 20; ++j) lg[j] = 0.f;
#pragma unroll
      for (int qd = 0; qd < 4; ++qd) { const int c = qd * 256 + lane * 4;
        const f32x4 x1 = (z[qd] - mean) * rstd * g1[qd] + b1[qd]; *(f32x4*)(xo + (size_t)tok * 1024 + c) = x1;
        const f32x4 hv = x1 * sc[qd] + sh[qd];
        u32x2 hw; hw.x = cvt_pk(hv[0], hv[1]); hw.y = cvt_pk(hv[2], hv[3]); *(u32x2*)(H + (size_t)tok * 1024 + c) = hw;
#pragma unroll
        for (int j = 0; j < 20; ++j) { const f32x4 w = *(const LAS f32x4*)(wr + j * 1024 + c); lg[j] += (hv[0] * w[0] + hv[1] * w[1]) + (hv[2] * w[2] + hv[3] * w[3]); } }
#pragma unroll
      for (int j = 0; j < 20; ++j) part[j * 64 + lane] = lg[j];
      asm volatile("s_waitcnt lgkmcnt(0)" ::: "memory");
      if (lane < 20) { float a = 0.f;
#pragma unroll
        for (int k = 0; k < 16; ++k) { const f32x4 v = *(const LAS f32x4*)(part + lane * 64 + k * 4); a += (v[0] + v[1]) + (v[2] + v[3]); }
        lgt[lt * 20 + lane] = a; }
      asm volatile("s_waitcnt lgkmcnt(0)" ::: "memory");
    }
    __syncthreads();
    if (tid < 128) {
      float lg[20];
#pragma unroll
      for (int j = 0; j < 20; ++j) lg[j] = lgt[tid * 20 + j];
      float gl[4]; float m = -3e38f;
#pragma unroll
      for (int j = 0; j < 4; ++j) { gl[j] = lg[j] + p.in[I_BRG][j]; m = fmaxf(m, gl[j]); }
      float ssum = 0.f;
#pragma unroll
      for (int j = 0; j < 4; ++j) { gl[j] = expf(gl[j] - m); ssum += gl[j]; }
      int gt = 0; float pg = gl[0];
#pragma unroll
      for (int j = 1; j < 4; ++j) if (gl[j] > pg) { pg = gl[j]; gt = j; }
      pg /= ssum;
      float el[4]; float em = -3e38f;
#pragma unroll
      for (int j = 0; j < 4; ++j) { const float v = gt == 0 ? lg[4 + j] : gt == 1 ? lg[8 + j] : gt == 2 ? lg[12 + j] : lg[16 + j]; el[j] = v + p.in[I_BRE][gt * 4 + j]; em = fmaxf(em, el[j]); }
      float es = 0.f;
#pragma unroll
      for (int j = 0; j < 4; ++j) { el[j] = expf(el[j] - em); es += el[j]; }
      int i1 = 0; float p1 = el[0];
#pragma unroll
      for (int j = 1; j < 4; ++j) if (el[j] > p1) { p1 = el[j]; i1 = j; }
      int i2 = -1; float p2 = -1.f;
#pragma unroll
      for (int j = 0; j < 4; ++j) if (j != i1 && el[j] > p2) { p2 = el[j]; i2 = j; }
      const float w1 = p1 / (p1 + p2) * pg, w2 = p2 / (p1 + p2) * pg;
      const int a = i1 < i2 ? i1 : i2, bb = i1 < i2 ? i2 : i1; const float wa = i1 < i2 ? w1 : w2, wb = i1 < i2 ? w2 : w1;
      const int pr = a == 0 ? bb - 1 : (a == 1 ? bb + 1 : 5);
      tb[tid] = gt * 6 + pr; tw[tid * 2] = wa; tw[tid * 2 + 1] = wb;
    }
    __syncthreads();
    if (tid < 24) { int c = 0; for (int j = 0; j < 128; ++j) c += (tb[j] == tid); base[tid] = c ? atomicAdd(&cnt[tid], c) : 0; }
    __syncthreads();
    if (tid < 128) { const int bk = tb[tid]; int r = 0; for (int j = 0; j < tid; ++j) r += (tb[j] == bk);
      TokInfo ti; ti.bucket = bk; ti.pos = base[bk] + r; ti.wa = tw[tid * 2]; ti.wb = tw[tid * 2 + 1]; TI[t0 + tid] = ti; }
    __syncthreads();
  }
}

__device__ __forceinline__ void phase9(const MP& p, LAS unsigned char* lds) {
  const int tid = threadIdx.x, wid = tid >> 6, lane = tid & 63; unsigned char* ws = p.ws;
  LAS int* off = (LAS int*)lds;
  LAS int* cn = off + 32;
  int* cw = (int*)(ws + WS_CNT); int* ROWTOK = (int*)(ws + WS_ROWTOK); f32x2* ROWW = (f32x2*)(ws + WS_ROWTOK + 256 * 1024);
  if (tid == 0) { int o = 0; for (int k = 0; k < 24; ++k) { const int c = cw[k]; cn[k] = c; off[k] = o; o += ((c + 255) >> 8) << 8; } off[24] = o;
    if (blockIdx.x == 0) { cw[CW_NT] = o >> 8; int t = 0; for (int k = 0; k < 24; ++k) for (int j = 0; j < ((cn[k] + 255) >> 8); ++j) cw[CW_TB + t++] = k; } }
  __syncthreads();
  for (int k = 0; k < 24; ++k) { const int lo = off[k] + cn[k], hi = off[k + 1]; for (int r = lo + blockIdx.x * NTH + tid; r < hi; r += gridDim.x * NTH) ROWTOK[r] = -1; }
  const TokInfo* TI = (const TokInfo*)(ws + WS_TOKINFO); const bf16_t* H = (const bf16_t*)(ws + WS_H); bf16_t* HP = (bf16_t*)(ws + WS_HPERM);
  for (int tok = blockIdx.x * 8 + wid; tok < NLAT; tok += gridDim.x * 8) {
    const TokInfo ti = TI[tok]; const int row = off[ti.bucket] + ti.pos;
    if (lane == 0) { ROWTOK[row] = tok; f32x2 w = {ti.wa, ti.wb}; ROWW[row] = w; }
    const u32x4* src = (const u32x4*)(H + (size_t)tok * 1024); u32x4* dst = (u32x4*)(HP + (size_t)row * 1024);
    const u32x4 a = src[lane], b2 = src[64 + lane]; dst[lane] = a; dst[64 + lane] = b2;
  }
}

struct MoeOrder {
  int nwg, G, c; const int* tb;
  __device__ void init(const int* cw, int G_, int c_, bool w1_) { nwg = cw[CW_NT] * 4; G = G_; c = c_; tb = cw + CW_TB; w1 = w1_; }
  bool w1;
  __device__ bool next(int i, pg8::Unit& u) const { const int L = i * G + c; if (L >= nwg) return false; const int bk = tb[L >> 2], pnl = L & 3; u.pm = L >> 2; u.aux = bk * 4 + pnl;
    if (w1) { const int g = bk / 6, pr = bk - g * 6; int a, b; pair_ab(pr, a, b); u.pn = (g * 4 + ((pnl >> 1) ? b : a)) * 2 + (pnl & 1); } else u.pn = bk * 4 + pnl; return true; }
  __device__ __forceinline__ void a_ready(const pg8::Unit&) const {}
  __device__ __forceinline__ void done(const pg8::Unit&) const {}
};

struct EpiSwiglu {
  static constexpr bool PERM = true, AFTER_DRAIN = false;
  unsigned char* ws;
  __device__ __forceinline__ void operator()(const f32x4 (&acc)[2][2][4][2], const pg8::Unit& u, int wr, int wc, int fr, int fq) const {
    asm volatile("" : "+v"(fr), "+v"(fq));
    const unsigned row0 = u.pm * 256 + wr * 64 + fr; const unsigned pnl = u.aux & 3, slot = pnl >> 1, hb = pnl & 1;
    const unsigned colb = (slot * 256u + hb * 128u + wc * 32 + 8 * fq) * 2u;
#pragma unroll
    for (int ai = 0; ai < 2; ++ai)
#pragma unroll
      for (int m = 0; m < 4; ++m) {
        const unsigned row = row0 + ai * 128 + m * 16; const float w = *(const float*)(ws + (unsigned)(WS_ROWTOK + 256 * 1024 + (row * 2u + slot) * 4u));
        float he[8];
#pragma unroll
        for (int n = 0; n < 2; ++n)
#pragma unroll
          for (int e = 0; e < 4; ++e) { const float g = acc[ai][0][m][n][e], up = acc[ai][1][m][n][e]; he[n * 4 + e] = g / (1.f + __expf(-g)) * up * w; }
        u32x4 o; o.x = cvt_pk(he[0], he[1]); o.y = cvt_pk(he[2], he[3]); o.z = cvt_pk(he[4], he[5]); o.w = cvt_pk(he[6], he[7]);
        *(u32x4*)(ws + (unsigned)(WS_HE + row * 1024u + colb)) = o;
        asm volatile("" ::: "memory");
      }
  }
};
__device__ __forceinline__ void phase10(const MP& p, LAS unsigned char* lds) {
  int K = 1024; asm volatile("" : "+s"(K));
  pg8::Gemm g{(const bf16_t*)(p.ws + WS_HPERM), (const bf16_t*)(p.ws + WS_W1T), 0, 0, K};
  MoeOrder S; S.init((const int*)(p.ws + WS_CNT), gridDim.x, blockIdx.x, true);
  EpiSwiglu E{p.ws};
  pg8::gemm_phase<EpiSwiglu, MoeOrder, true, true>(lds, g, S, E);
}

struct EpiMoe {
  static constexpr bool PERM = false, AFTER_DRAIN = false;
  float* out; unsigned char* ws; float* wout; size_t st2;
  __device__ __forceinline__ void operator()(const f32x4 (&acc)[2][2][4][2], const pg8::Unit& u, int wr, int wc, int fr, int fq) const {
    asm volatile("" : "+v"(fr), "+v"(fq));
    const unsigned row0 = u.pm * 256 + wr * 64 + fr; const unsigned pnl = u.aux & 3; const unsigned col0 = pnl * 256 + wc * 32 + 4 * fq;
#pragma unroll
    for (int ai = 0; ai < 2; ++ai)
#pragma unroll
      for (int m = 0; m < 4; ++m) {
        const unsigned row = row0 + ai * 128 + m * 16; const int tok = *(const int*)(ws + (unsigned)(WS_ROWTOK + row * 4u));
        const bool live = tok >= 0; const unsigned tk = live ? (unsigned)tok : 0u; const unsigned b = tk >> 12; const unsigned eo = tk * 1024u + col0; float s = 0.f, q = 0.f;
#pragma unroll
        for (int bj = 0; bj < 2; ++bj)
#pragma unroll
          for (int n = 0; n < 2; ++n) { const f32x4 gt = *(const f32x4*)(ws + (unsigned)(WS_MOD + (b * 6144u + 5120u + col0 + bj * 128 + n * 16) * 4u));
            const f32x4 xv = *(const f32x4*)(out + eo + bj * 128 + n * 16); const f32x4 z = xv * ALPHA + gt * acc[ai][bj][m][n];
            if (live) *(f32x4*)(wout + eo + bj * 128 + n * 16) = z; s += (z[0] + z[1]) + (z[2] + z[3]); q += (z[0] * z[0] + z[1] * z[1]) + (z[2] * z[2] + z[3] * z[3]); }
        s += __shfl_xor(s, 16); s += __shfl_xor(s, 32); q += __shfl_xor(q, 16); q += __shfl_xor(q, 32);
        if (fq == 0 && live) { f32x2 st = {s, q}; *(f32x2*)(ws + (unsigned)(st2 + (tk * 16u + pnl * 4u + wc) * 8u)) = st; }
        asm volatile("" ::: "memory");
      }
  }
};
template <bool SH> __device__ __forceinline__ void phase11(const MP& p, LAS unsigned char* lds) {
  int K = 512; asm volatile("" : "+s"(K));
  pg8::Gemm g{(const bf16_t*)(p.ws + WS_HE), (const bf16_t*)(p.ws + WS_W2T), 0, 0, K};
  MoeOrder S; S.init((const int*)(p.ws + WS_CNT), gridDim.x, blockIdx.x, false);
  EpiMoe E{p.out, p.ws, SH ? (float*)(p.ws + 370 * MiB) : p.out, SH ? (size_t)(24 * MiB) : WS_ST2};
  pg8::gemm_phase<EpiMoe, MoeOrder, true, true>(lds, g, S, E);
}

template <bool SH> __device__ __forceinline__ void phase12(const MP& p) {
  const int tid = threadIdx.x, wid = tid >> 6, lane = tid & 63; float* out = p.out; float* wo = SH ? (float*)(p.ws + 370 * MiB) : p.out; const float* ST = (const float*)(p.ws + WS_ST2);
  for (int tok = blockIdx.x * 8 + wid; tok < NLAT; tok += gridDim.x * 8) {
    float s = 0.f, q = 0.f; if (lane < 16) { const f32x2 v = *(const f32x2*)(ST + ((size_t)tok * 16 + lane) * 2); s = v[0]; q = v[1]; }
#pragma unroll
    for (int o = 1; o < 16; o <<= 1) { s += __shfl_xor(s, o); q += __shfl_xor(q, o); }
    s = __shfl(s, 0); q = __shfl(q, 0);
    const float mean = s * (1.f / 1024.f), rstd = rsqrtf(fmaxf(q * (1.f / 1024.f) - mean * mean, 0.f) + EPS);
#pragma unroll
    for (int qd = 0; qd < 4; ++qd) { const int c = qd * 256 + lane * 4; float* zp = out + (size_t)tok * 1024 + c;
      const f32x4 z = *(const f32x4*)zp; const f32x4 g2 = *(const f32x4*)(p.in[I_LN2G] + c), b2 = *(const f32x4*)(p.in[I_LN2B] + c);
      *(f32x4*)(wo + (size_t)tok * 1024 + c) = (z - mean) * rstd * g2 + b2; }
  }
}
}
namespace mk {
namespace cg = cooperative_groups;
__global__ void __launch_bounds__(NTH, 2) mega(MP p) {
  extern __shared__ __attribute__((aligned(16))) unsigned char lds_raw[];
  LAS unsigned char* lds = (LAS unsigned char*)lds_raw;
  const int lo = p.ph_lo, hi = p.ph_hi;
#define IN(k) (lo <= (k) && (k) < hi)
#define SEAM(k) do { if (IN(k) && IN((k) + 1)) { xcd_barrier(xb); } } while (0)
  volatile LAS unsigned* xst = (volatile LAS unsigned*)(lds + LDS_BYTES - 16);
  if (threadIdx.x < 4) xst[threadIdx.x] = 0u;
  __syncthreads();
  XcdBarrier xb = xcd_barrier_post((unsigned*)(p.ws + WS_BAR), xst);
#ifndef REP
#define REP -1
#endif
#define RPT(k, call) do { call; if ((REP) == (k)) { call; } } while (0)
  if (IN(0)) RPT(0, phase0(p, lds));
  SEAM(0);
  if (IN(1)) RPT(1, phase1(p));
  SEAM(1);
  if (IN(2)) RPT(2, phase2(p, lds));
  SEAM(2);
  if (IN(3)) RPT(3, phase3(p, lds));
  SEAM(3);
  if (IN(4)) { RPT(4, phase4_gemm(p, lds)); RPT(14, gla::stage1(p, lds)); }
  SEAM(4);
  if (IN(5)) { if (REP == 15) gla::stage2<true>(p); gla::stage2<false>(p); RPT(5, phase5_attn(p, lds)); }
  SEAM(5);
  if (IN(6)) { RPT(6, gla::stage3(p, lds)); RPT(16, prep_expert_weights(p, lds)); }
  SEAM(6);
  if (IN(7)) RPT(7, phase7(p, lds));
  SEAM(7);
  if (IN(8)) { if (REP == 8) phase8<true>(p, lds); phase8<false>(p, lds); if (REP == 20) for (int q_ = 0; q_ < 10; ++q_) xcd_barrier(xb); }
  SEAM(8);
  if (IN(9)) RPT(9, phase9(p, lds));
  SEAM(9);
  if (IN(10)) RPT(10, phase10(p, lds));
  SEAM(10);
  if (IN(11)) { if (REP == 11) phase11<true>(p, lds); phase11<false>(p, lds); }
  SEAM(11);
  if (IN(12)) { if (REP == 12) phase12<true>(p); phase12<false>(p); }
#undef IN
#undef SEAM
}
}
extern "C" void kernel_launch(void* const* d_in, const int* in_sizes, int n_in,
                              void* d_out, int out_size, void* d_ws, size_t ws_size, hipStream_t stream) {
  static int grid = 0;
  if (!grid) {
    if (hipFuncSetAttribute((const void*)mk::mega, hipFuncAttributeMaxDynamicSharedMemorySize, mk::LDS_BYTES) != hipSuccess) { fprintf(stderr, "set attr failed\n"); return; }
    int dev = 0, cus = 0, per_cu = 0;
    hipGetDevice(&dev); hipDeviceGetAttribute(&cus, hipDeviceAttributeMultiprocessorCount, dev);
    hipOccupancyMaxActiveBlocksPerMultiprocessor(&per_cu, (const void*)mk::mega, mk::NTH, mk::LDS_BYTES);
    if (per_cu < 1 || cus < 1) { fprintf(stderr, "occupancy query: %d blocks/CU, %d CUs\n", per_cu, cus); return; }
    grid = cus;
  }
  if (ws_size < mk::WS_NEED || n_in != 28 || out_size != mk::NLAT * mk::D) { fprintf(stderr, "unexpected sizes\n"); return; }
  mk::MP a{}; for (int i = 0; i < 28; ++i) a.in[i] = (const float*)d_in[i]; a.out = (float*)d_out; a.ws = (unsigned char*)d_ws;
  a.ph_lo = 0; a.ph_hi = 13; a.coop = 1; a.pad = 0;
  (void)hipMemsetAsync((char*)d_ws + mk::WS_BAR, 0, 16384, stream);
  void* args[] = {&a};
  hipError_t e = hipLaunchCooperativeKernel((const void*)mk::mega, dim3(grid), dim3(mk::NTH), args, mk::LDS_BYTES, stream);
  if (e != hipSuccess) fprintf(stderr, "cooperative launch failed: %s (grid %d)\n", hipGetErrorString(e), grid);
}
```
